# Optimizing an MI355X kernel written in HIP

```python
import jax, jax.numpy as jnp
from jax import lax
import numpy as np

D_MODEL = 1024
BATCH = 4
SEQ = 8192
DEPTH = 1
DEC_BATCH = 32
DEC_SEQ = 64
PAST_LEN = 1024

CHUNK = 64
D_RNN = D_MODEL
N_LRU_BLOCKS = 16
LRU_BLOCK = D_RNN // N_LRU_BLOCKS
LRU_C = 8.0
CONV_W = 4
HEAD_DIM = 64
N_HEADS = D_MODEL // HEAD_DIM
N_KV_HEADS = 4
GROUP = N_HEADS // N_KV_HEADS
Q_W = N_HEADS * HEAD_DIM
KV_W = N_KV_HEADS * HEAD_DIM
ROT_DIM = HEAD_DIM // 4
ROPE_THETA = 500000.0
WINDOW = 128
WINDOW_CHUNKS = WINDOW // CHUNK
D_FF = 2816
FFN_CONV_W = 3
D_IN = D_RNN + D_RNN + Q_W + 2 * KV_W + D_RNN + Q_W
RMS_EPS = 1e-6
NEG_INF = -1e30
ATTN_CACHE = min(WINDOW, PAST_LEN)

kernel_name = "griffin_swa_sink_convffn_stream_step"


def rmsnorm(x, g):
    x32 = x.astype(jnp.float32)
    y = x32 * lax.rsqrt(jnp.mean(x32 * x32, axis=-1, keepdims=True) + RMS_EPS)
    return (y * g.astype(jnp.float32)).astype(x.dtype)


def causal_dwconv(x, buf, w, b):
    width = w.shape[0]
    t = x.shape[1]
    xp = jnp.concatenate([buf.astype(x.dtype), x], axis=1)
    y = b.astype(x.dtype) + sum(w[j].astype(x.dtype) * xp[:, j:j + t] for j in range(width))
    return y, xp[:, -(width - 1):]


def rope_partial(x, pos):
    half = ROT_DIM // 2
    inv_freq = jnp.power(ROPE_THETA, -jnp.arange(half, dtype=jnp.float32) * (2.0 / ROT_DIM))
    ang = pos.astype(jnp.float32)[:, None] * inv_freq[None, :]
    cos = jnp.cos(ang)[None, :, None, :]
    sin = jnp.sin(ang)[None, :, None, :]
    x32 = x.astype(jnp.float32)
    x1 = x32[..., :half]
    x2 = x32[..., half:ROT_DIM]
    out = jnp.concatenate([x1 * cos - x2 * sin, x2 * cos + x1 * sin, x32[..., ROT_DIM:]], axis=-1)
    return out.astype(x.dtype)


def sink_softmax(logits, sink):
    m = jnp.maximum(jnp.max(logits, axis=-1, keepdims=True), sink)
    e = jnp.exp(logits - m)
    return e / (jnp.sum(e, axis=-1, keepdims=True) + jnp.exp(sink - m))


def band_attention(q, k, v, sinks):
    b, s = q.shape[:2]
    nc = s // CHUNK
    qc = q.reshape(b, nc, CHUNK, N_KV_HEADS, GROUP, HEAD_DIM)
    pad = ((0, 0), (WINDOW_CHUNKS * CHUNK, 0), (0, 0), (0, 0))
    kp = jnp.pad(k, pad).reshape(b, nc + WINDOW_CHUNKS, CHUNK, N_KV_HEADS, HEAD_DIM)
    vp = jnp.pad(v, pad).reshape(b, nc + WINDOW_CHUNKS, CHUNK, N_KV_HEADS, HEAD_DIM)
    kb = jnp.concatenate([kp[:, j:j + nc] for j in range(WINDOW_CHUNKS + 1)], axis=2)
    vb = jnp.concatenate([vp[:, j:j + nc] for j in range(WINDOW_CHUNKS + 1)], axis=2)
    scores = jnp.einsum('bnqkgd,bnskd->bnkgqs', qc, kb,
                        preferred_element_type=jnp.float32) * (HEAD_DIM ** -0.5)
    key_chunk_off = jnp.repeat(jnp.arange(WINDOW_CHUNKS + 1) - WINDOW_CHUNKS, CHUNK)
    valid = (jnp.arange(nc)[:, None] + key_chunk_off[None, :]) >= 0
    scores = jnp.where(valid[None, :, None, None, None, :], scores, NEG_INF)
    p = sink_softmax(scores, sinks.astype(jnp.float32)[None, None, :, :, None, None])
    o = jnp.einsum('bnkgqs,bnskd->bnqkgd', p.astype(v.dtype), vb)
    return o.reshape(b, s, Q_W)


def cached_attention(q, k, v, k_cache, v_cache, sinks):
    b, t = q.shape[:2]
    kk = jnp.concatenate([k_cache.astype(k.dtype), k], axis=1)
    vv = jnp.concatenate([v_cache.astype(v.dtype), v], axis=1)
    scores = jnp.einsum('btkgd,bskd->bkgts', q, kk,
                        preferred_element_type=jnp.float32) * (HEAD_DIM ** -0.5)
    p = sink_softmax(scores, sinks.astype(jnp.float32)[None, :, :, None, None])
    o = jnp.einsum('bkgts,bskd->btkgd', p.astype(vv.dtype), vv)
    return o.reshape(b, t, Q_W), kk[:, -ATTN_CACHE:], vv[:, -ATTN_CACHE:]


def rg_lru(x, h0, w_a, b_a, w_i, b_i, lam):
    b, t, _ = x.shape
    xb = x.reshape(b, t, N_LRU_BLOCKS, LRU_BLOCK)
    r = jax.nn.sigmoid((jnp.einsum('btnc,ncd->btnd', xb, w_a).reshape(b, t, D_RNN) + b_a).astype(jnp.float32))
    i = jax.nn.sigmoid((jnp.einsum('btnc,ncd->btnd', xb, w_i).reshape(b, t, D_RNN) + b_i).astype(jnp.float32))
    log_a = -LRU_C * r * jax.nn.softplus(-lam.astype(jnp.float32))
    a = jnp.exp(log_a)
    u = jnp.sqrt(-jnp.expm1(2.0 * log_a)) * (i * x.astype(jnp.float32))
    u = u.at[:, 0].add(a[:, 0] * h0.astype(jnp.float32))

    def combine(left, right):
        a_l, u_l = left
        a_r, u_r = right
        return a_l * a_r, a_r * u_l + u_r

    _, h = lax.associative_scan(combine, (a, u), axis=1)
    return h.astype(x.dtype), h[:, -1].astype(x.dtype)


def trunk(x, pos, cache_k, cache_v, lru_h, lru_conv, ffn_conv,
          norm_mix, w_in, lru_conv_w, lru_conv_b, lru_gate_a_w, lru_gate_a_b,
          lru_gate_i_w, lru_gate_i_b, lru_lambda, attn_sinks, w_out,
          norm_ffn, w_up, ffn_conv_w, ffn_conv_b, w_down, norm_final):
    b, t, _ = x.shape
    first = cache_k is None
    cuts = np.cumsum([D_RNN, D_RNN, Q_W, KV_W, KV_W, D_RNN]).tolist()
    new_k, new_v, new_h, new_lc, new_fc = [], [], [], [], []
    for l in range(DEPTH):
        xn = rmsnorm(x, norm_mix[l])
        proj = xn @ w_in[l]
        x_rnn, y_gate, q, k, v, g_rnn, g_attn = jnp.split(proj, cuts, axis=-1)
        if first:
            h0 = jnp.zeros((b, D_RNN), x.dtype)
            cbuf = jnp.zeros((b, CONV_W - 1, D_RNN), x.dtype)
        else:
            h0 = lru_h[l]
            cbuf = lru_conv[l]
        xc, cbuf_new = causal_dwconv(x_rnn, cbuf, lru_conv_w[l], lru_conv_b[l])
        h, h_last = rg_lru(xc, h0, lru_gate_a_w[l], lru_gate_a_b[l],
                           lru_gate_i_w[l], lru_gate_i_b[l], lru_lambda[l])
        y_rnn = h * jax.nn.gelu(y_gate)
        qh = rope_partial(q.reshape(b, t, N_HEADS, HEAD_DIM), pos).reshape(b, t, N_KV_HEADS, GROUP, HEAD_DIM)
        kh = rope_partial(k.reshape(b, t, N_KV_HEADS, HEAD_DIM), pos)
        vh = v.reshape(b, t, N_KV_HEADS, HEAD_DIM)
        sinks = attn_sinks[l].reshape(N_KV_HEADS, GROUP)
        if first:
            y_attn = band_attention(qh, kh, vh, sinks)
            k_keep = kh[:, -ATTN_CACHE:]
            v_keep = vh[:, -ATTN_CACHE:]
        else:
            y_attn, k_keep, v_keep = cached_attention(qh, kh, vh, cache_k[l], cache_v[l], sinks)
        mixed = jax.nn.sigmoid(g_rnn) * y_rnn + jax.nn.sigmoid(g_attn) * y_attn
        x = x + mixed @ w_out[l]
        xn2 = rmsnorm(x, norm_ffn[l])
        up = xn2 @ w_up[l]
        fbuf = jnp.zeros((b, FFN_CONV_W - 1, 2 * D_FF), x.dtype) if first else ffn_conv[l]
        up_c, fbuf_new = causal_dwconv(up, fbuf, ffn_conv_w[l], ffn_conv_b[l])
        gate, val = jnp.split(up_c, 2, axis=-1)
        x = x + (jax.nn.silu(gate) * val) @ w_down[l]
        new_k.append(k_keep)
        new_v.append(v_keep)
        new_h.append(h_last)
        new_lc.append(cbuf_new)
        new_fc.append(fbuf_new)
    y = rmsnorm(x, norm_final)
    return (y, jnp.stack(new_k), jnp.stack(new_v), jnp.stack(new_h),
            jnp.stack(new_lc), jnp.stack(new_fc))


def setup_inputs(seed: int = 0) -> dict:
    key = jax.random.key(seed)
    ks = jax.random.split(key, 32)
    f32 = jnp.float32

    def nrm(k, shape, scale):
        return jax.random.normal(k, shape, f32) * scale

    u = jax.random.uniform(ks[15], (DEPTH, D_RNN), f32, 0.9, 0.999)
    s = u ** (1.0 / LRU_C)
    lam = jnp.log(s) - jnp.log1p(-s)
    return {
        'x_prompt': nrm(ks[0], (BATCH, SEQ, D_MODEL), 1.0),
        'x_sample': nrm(ks[1], (DEC_BATCH, DEC_SEQ, D_MODEL), 1.0),
        'cache_attn_k': nrm(ks[2], (DEPTH, DEC_BATCH, ATTN_CACHE, N_KV_HEADS, HEAD_DIM), 1.0),
        'cache_attn_v': nrm(ks[3], (DEPTH, DEC_BATCH, ATTN_CACHE, N_KV_HEADS, HEAD_DIM), 1.0),
        'state_lru_h': nrm(ks[4], (DEPTH, DEC_BATCH, D_RNN), 0.5),
        'state_lru_conv': nrm(ks[5], (DEPTH, DEC_BATCH, CONV_W - 1, D_RNN), 0.5),
        'state_ffn_conv': nrm(ks[6], (DEPTH, DEC_BATCH, FFN_CONV_W - 1, 2 * D_FF), 0.5),
        'norm_mix': 1.0 + nrm(ks[7], (DEPTH, D_MODEL), 0.1),
        'w_in': nrm(ks[8], (DEPTH, D_MODEL, D_IN), D_MODEL ** -0.5),
        'lru_conv_w': nrm(ks[9], (DEPTH, CONV_W, D_RNN), CONV_W ** -0.5),
        'lru_conv_b': nrm(ks[10], (DEPTH, D_RNN), 0.02),
        'lru_gate_a_w': nrm(ks[11], (DEPTH, N_LRU_BLOCKS, LRU_BLOCK, LRU_BLOCK), LRU_BLOCK ** -0.5),
        'lru_gate_a_b': nrm(ks[12], (DEPTH, D_RNN), 0.02),
        'lru_gate_i_w': nrm(ks[13], (DEPTH, N_LRU_BLOCKS, LRU_BLOCK, LRU_BLOCK), LRU_BLOCK ** -0.5),
        'lru_gate_i_b': nrm(ks[14], (DEPTH, D_RNN), 0.02),
        'lru_lambda': lam,
        'attn_sinks': nrm(ks[16], (DEPTH, N_HEADS), 0.5),
        'w_out': nrm(ks[17], (DEPTH, D_MODEL, D_MODEL), D_MODEL ** -0.5),
        'norm_ffn': 1.0 + nrm(ks[18], (DEPTH, D_MODEL), 0.1),
        'w_up': nrm(ks[19], (DEPTH, D_MODEL, 2 * D_FF), D_MODEL ** -0.5),
        'ffn_conv_w': nrm(ks[20], (DEPTH, FFN_CONV_W, 2 * D_FF), FFN_CONV_W ** -0.5),
        'ffn_conv_b': nrm(ks[21], (DEPTH, 2 * D_FF), 0.02),
        'w_down': nrm(ks[22], (DEPTH, D_FF, D_MODEL), D_FF ** -0.5),
        'norm_final': 1.0 + nrm(ks[23], (D_MODEL,), 0.1),
    }


def reference(x_prompt, x_sample, cache_attn_k, cache_attn_v, state_lru_h, state_lru_conv,
              state_ffn_conv, norm_mix, w_in, lru_conv_w, lru_conv_b, lru_gate_a_w,
              lru_gate_a_b, lru_gate_i_w, lru_gate_i_b, lru_lambda, attn_sinks, w_out,
              norm_ffn, w_up, ffn_conv_w, ffn_conv_b, w_down, norm_final):
    pos_prompt = jnp.arange(SEQ, dtype=jnp.int32)
    pos_sample = PAST_LEN + jnp.arange(DEC_SEQ, dtype=jnp.int32)
    y_prompt, k_p, v_p, h_p, lc_p, fc_p = trunk(
        x_prompt, pos_prompt, None, None, None, None, None,
        norm_mix, w_in, lru_conv_w, lru_conv_b, lru_gate_a_w, lru_gate_a_b,
        lru_gate_i_w, lru_gate_i_b, lru_lambda, attn_sinks, w_out,
        norm_ffn, w_up, ffn_conv_w, ffn_conv_b, w_down, norm_final)
    y_sample, k_s, v_s, h_s, lc_s, fc_s = trunk(
        x_sample, pos_sample, cache_attn_k, cache_attn_v, state_lru_h, state_lru_conv, state_ffn_conv,
        norm_mix, w_in, lru_conv_w, lru_conv_b, lru_gate_a_w, lru_gate_a_b,
        lru_gate_i_w, lru_gate_i_b, lru_lambda, attn_sinks, w_out,
        norm_ffn, w_up, ffn_conv_w, ffn_conv_b, w_down, norm_final)
    return (y_prompt, y_sample, k_p, v_p, h_p, lc_p, fc_p, k_s, v_s, h_s, lc_s, fc_s)
```

```cpp
#include <hip/hip_runtime.h>
#include <cstdio>
#include <cstdint>
#include <cmath>
namespace pg8 {
#define PG8_LAS __attribute__((address_space(3)))
typedef unsigned short bf16_t;
typedef short bf16x8 __attribute__((ext_vector_type(8)));
typedef float f32x4 __attribute__((ext_vector_type(4)));
typedef unsigned u32x4 __attribute__((ext_vector_type(4)));
constexpr int BM = 256, BK = 64, HALF = 128, HTB = HALF * BK * 2  , STAGE_BYTES = 8 * HTB, NXCD = 8, WGM = 6;

__host__ __device__ __forceinline__ int lds_byte(int r, int c) { const int st = (r >> 4) * 2 + (c >> 5), rr = r & 15, cc = c & 31, ob = rr * 64 + cc * 2; return st * 1024 + (ob ^ (((ob >> 9) & 1) << 5)); }
__host__ __device__ __forceinline__ void stage_rc(int b, int& R, int& C) { const int st = b / 1024, sb = b % 1024, swz = sb ^ (((sb >> 9) & 1) << 5); R = (st >> 1) * 16 + swz / 64; C = (st & 1) * 32 + (swz % 64) / 2; }
__host__ __device__ __forceinline__ int perm32(int rho) { const int n = rho >> 4, i = rho & 15; return 8 * (i >> 2) + 4 * n + (i & 3); }

struct Unit { int pm, pn; };
struct Gemm { const bf16_t* A; const bf16_t* Bt; int M, N, K; int ld = 0; };

struct StaticOrder {
    int nM, nN, nwg, G, c;
    __host__ __device__ __forceinline__ void init(int M, int N, int G_, int c_) { nM = M / BM; nN = N / BM; nwg = nM * nN; G = G_; c = c_; }
    __host__ __device__ __forceinline__ bool next(int i, Unit& u) const {
        const long L = (long)i * G + c; if (L >= nwg) return false;
        int wgid = (int)L; { const int q = nwg / NXCD, r = nwg % NXCD, xcd = wgid % NXCD, off = wgid / NXCD; wgid = (xcd < r ? xcd * (q + 1) : r * (q + 1) + (xcd - r) * q) + off; }
        const int nig = WGM * nN, gid = wgid / nig, fm = gid * WGM, gsz = (nM - fm) < WGM ? (nM - fm) : WGM;
        u.pm = fm + ((wgid % nig) % gsz); u.pn = (wgid % nig) / gsz; return true;
    }
    __device__ __forceinline__ void a_ready(const Unit&) const {}
    __device__ __forceinline__ void done(const Unit&) const {}
};

template <class Epi, class Sched, bool ALIGN_EPI = false, bool SP2 = false>
__device__ __forceinline__ void gemm_phase(PG8_LAS unsigned char* lds, const Gemm g, const Sched& S, const Epi& E) {
    int tid_ = threadIdx.x; asm volatile("" : "+v"(tid_));
    const int tid = tid_, wid = __builtin_amdgcn_readfirstlane(tid >> 6), lane = tid & 63, wr = wid >> 2, wc = wid & 3, fr = lane & 15, fq = lane >> 4;
    const int K = g.ld ? g.ld : g.K, nt = g.K / BK;
    unsigned voffA[2], voffB[2];
#pragma unroll
    for (int i = 0; i < 2; ++i) { int R, C; stage_rc(tid * 16 + i * 8192, R, C); const int Rb = Epi::PERM ? ((R & ~31) + perm32(R & 31)) : R;
        voffA[i] = (unsigned)(R * K + C) * 2u; voffB[i] = (unsigned)(Rb * K + C) * 2u; }
    const size_t kstep = (size_t)(BK * 2);
    const size_t hstep = (size_t)HALF * K * 2;
    const size_t tstep = 2 * hstep;
    const unsigned ldsw = (unsigned)wid * 1024u;
    const int aoff = lds_byte(wr * 64 + fr, fq * 8), boff = lds_byte(wc * 32 + fr, fq * 8);
#define PG8_SA(b, h) (((b) * 2 + (h)) * HTB)
#define PG8_SB(b, h) ((4 + (b) * 2 + (h)) * HTB)
#define PG8_STAGE(bufoff, gbase, voff) do { _Pragma("unroll") for (int _i = 0; _i < 2; ++_i) \
        __builtin_amdgcn_global_load_lds((const unsigned*)((const char*)(gbase) + (voff)[_i]), (PG8_LAS unsigned*)(lds + (bufoff) + ldsw + _i * 8192), 16, 0, 0); } while (0)
#define PG8_LDA(dst, b, h) do { _Pragma("unroll") for (int m = 0; m < 4; ++m) _Pragma("unroll") for (int k = 0; k < 2; ++k) dst[m][k] = *(const PG8_LAS bf16x8*)(lds + PG8_SA(b, h) + aoff + m * 2048 + k * 1024); } while (0)
#define PG8_LDB(dst, b, h) do { _Pragma("unroll") for (int n = 0; n < 2; ++n) _Pragma("unroll") for (int k = 0; k < 2; ++k) dst[n][k] = *(const PG8_LAS bf16x8*)(lds + PG8_SB(b, h) + boff + n * 2048 + k * 1024); } while (0)
#define PG8_MMA(ai, bj, At, Bt) do { __builtin_amdgcn_s_setprio(1); _Pragma("unroll") for (int m = 0; m < 4; ++m) _Pragma("unroll") for (int n = 0; n < 2; ++n) _Pragma("unroll") for (int k = 0; k < 2; ++k) \
        acc[ai][bj][m][n] = __builtin_amdgcn_mfma_f32_16x16x32_bf16(Bt[n][k], At[m][k], acc[ai][bj][m][n], 0, 0, 0); __builtin_amdgcn_s_setprio(0); } while (0)
#define PG8_WAIT_V(n) asm volatile("s_waitcnt vmcnt(" #n ")" ::: "memory")
#define PG8_WAIT_L(n) asm volatile("s_waitcnt lgkmcnt(" #n ")" ::: "memory")
#define PG8_BAR __builtin_amdgcn_s_barrier()
#define PG8_SCHED __builtin_amdgcn_sched_barrier(0)
    Unit cur, nxt; int ui = 0;
    if (!S.next(0, cur)) return;
    f32x4 acc[2][2][4][2];
#pragma unroll
    for (int a = 0; a < 2; ++a)
#pragma unroll
        for (int b = 0; b < 2; ++b)
#pragma unroll
            for (int m = 0; m < 4; ++m)
#pragma unroll
                for (int n = 0; n < 2; ++n) acc[a][b][m][n] = (f32x4){0.f, 0.f, 0.f, 0.f};
    bf16x8 At[4][2], B0[2][2], B1[2][2];
    const char* cA = (const char*)g.A + (size_t)cur.pm * tstep; const char* cB = (const char*)g.Bt + (size_t)cur.pn * tstep;
    S.a_ready(cur);
    if constexpr (SP2) {
        PG8_STAGE(PG8_SB(0, 0), cB, voffB); PG8_STAGE(PG8_SB(0, 1), cB + hstep, voffB); PG8_STAGE(PG8_SA(0, 0), cA, voffA); PG8_STAGE(PG8_SA(0, 1), cA + hstep, voffA);
        if (wr == 1) PG8_BAR;
        PG8_WAIT_V(2); PG8_BAR;
        PG8_STAGE(PG8_SB(1, 0), cB + kstep, voffB); PG8_STAGE(PG8_SA(1, 0), cA + kstep, voffA); PG8_STAGE(PG8_SB(1, 1), cB + hstep + kstep, voffB);
        PG8_WAIT_V(6); PG8_BAR;
    } else {
        PG8_STAGE(PG8_SB(0, 0), cB, voffB); PG8_STAGE(PG8_SA(0, 0), cA, voffA); PG8_STAGE(PG8_SB(0, 1), cB + hstep, voffB); PG8_STAGE(PG8_SA(0, 1), cA + hstep, voffA);
        if (wr == 1) PG8_BAR;
        PG8_WAIT_V(4); PG8_BAR;
        PG8_STAGE(PG8_SB(1, 0), cB + kstep, voffB); PG8_STAGE(PG8_SA(1, 0), cA + kstep, voffA); PG8_STAGE(PG8_SB(1, 1), cB + hstep + kstep, voffB);
        PG8_WAIT_V(6); PG8_BAR;
    }
    for (;;) {
        const bool has_next = S.next(ui + 1, nxt);
        const char* nA = has_next ? (const char*)g.A + (size_t)nxt.pm * tstep : cA; const char* nB = has_next ? (const char*)g.Bt + (size_t)nxt.pn * tstep : cB;
        for (int t = 0; t < nt; t += 2) {
            const bool last = (t == nt - 2);
            const char* a1 = cA + (size_t)(t + 1) * kstep;
            const char* a2 = last ? nA : cA + (size_t)(t + 2) * kstep; const char* b2 = last ? nB : cB + (size_t)(t + 2) * kstep;
            const char* a3 = a2 + kstep; const char* b3 = b2 + kstep;
            if (last && has_next) S.a_ready(nxt);
            if constexpr (SP2) {
            PG8_LDB(B0, 0, 0); PG8_LDB(B1, 0, 1); PG8_SCHED; PG8_LDA(At, 0, 0); PG8_STAGE(PG8_SA(1, 1), a1 + hstep, voffA);
            PG8_WAIT_V(8); PG8_WAIT_L(0); PG8_BAR; PG8_MMA(0, 0, At, B0); PG8_MMA(0, 1, At, B1); PG8_BAR; PG8_SCHED;
            PG8_LDA(At, 0, 1); PG8_STAGE(PG8_SB(0, 0), b2, voffB); PG8_STAGE(PG8_SB(0, 1), b2 + hstep, voffB); PG8_STAGE(PG8_SA(0, 0), a2, voffA);
            PG8_WAIT_V(8); PG8_WAIT_L(0); PG8_BAR; PG8_MMA(1, 0, At, B0); PG8_MMA(1, 1, At, B1); PG8_BAR; PG8_SCHED;
            PG8_LDB(B0, 1, 0); PG8_LDB(B1, 1, 1); PG8_SCHED; PG8_LDA(At, 1, 0); PG8_STAGE(PG8_SA(0, 1), a2 + hstep, voffA);
            PG8_WAIT_V(8); PG8_WAIT_L(0); PG8_BAR; PG8_MMA(0, 0, At, B0); PG8_MMA(0, 1, At, B1); PG8_BAR; PG8_SCHED;
            PG8_LDA(At, 1, 1); PG8_STAGE(PG8_SB(1, 0), b3, voffB); PG8_STAGE(PG8_SB(1, 1), b3 + hstep, voffB); PG8_STAGE(PG8_SA(1, 0), a3, voffA);
            PG8_WAIT_V(8); PG8_WAIT_L(0); PG8_BAR; PG8_MMA(1, 0, At, B0); PG8_MMA(1, 1, At, B1); PG8_BAR; PG8_SCHED;
            } else {
            PG8_LDB(B0, 0, 0); PG8_SCHED; PG8_LDA(At, 0, 0); PG8_STAGE(PG8_SA(1, 1), a1 + hstep, voffA);
            PG8_WAIT_L(8); PG8_BAR; PG8_WAIT_L(0); PG8_MMA(0, 0, At, B0); PG8_BAR; PG8_SCHED;
            PG8_LDB(B1, 0, 1); PG8_STAGE(PG8_SB(0, 0), b2, voffB);
            PG8_BAR; PG8_WAIT_L(0); PG8_MMA(0, 1, At, B1); PG8_BAR;
            PG8_LDA(At, 0, 1); PG8_STAGE(PG8_SA(0, 0), a2, voffA);
            PG8_BAR; PG8_WAIT_L(0); PG8_MMA(1, 0, At, B0); PG8_BAR; PG8_SCHED;
            PG8_STAGE(PG8_SB(0, 1), b2 + hstep, voffB);
            PG8_WAIT_V(6); PG8_BAR; PG8_MMA(1, 1, At, B1); PG8_BAR;
            PG8_LDB(B0, 1, 0); PG8_SCHED; PG8_LDA(At, 1, 0); PG8_STAGE(PG8_SA(0, 1), a2 + hstep, voffA);
            PG8_WAIT_L(8); PG8_BAR; PG8_WAIT_L(0); PG8_MMA(0, 0, At, B0); PG8_BAR; PG8_SCHED;
            PG8_LDB(B1, 1, 1); PG8_STAGE(PG8_SB(1, 0), b3, voffB);
            PG8_BAR; PG8_WAIT_L(0); PG8_MMA(0, 1, At, B1); PG8_BAR;
            PG8_LDA(At, 1, 1); PG8_STAGE(PG8_SA(1, 0), a3, voffA);
            PG8_BAR; PG8_WAIT_L(0); PG8_MMA(1, 0, At, B0); PG8_BAR; PG8_SCHED;
            PG8_STAGE(PG8_SB(1, 1), b3 + hstep, voffB);
            PG8_WAIT_V(6); PG8_BAR; PG8_MMA(1, 1, At, B1); PG8_BAR;
            }
        }
        if constexpr (ALIGN_EPI) { if (wr == 0) PG8_BAR; }
        if constexpr (!Epi::AFTER_DRAIN) { E(acc, cur, wr, wc, fr, fq); S.done(cur); }
        if (!has_next) break;
#pragma unroll
        for (int a = 0; a < 2; ++a)
#pragma unroll
            for (int b = 0; b < 2; ++b)
#pragma unroll
                for (int m = 0; m < 4; ++m)
#pragma unroll
                    for (int n = 0; n < 2; ++n) acc[a][b][m][n] = (f32x4){0.f, 0.f, 0.f, 0.f};
        cur = nxt; cA = nA; cB = nB; ++ui;
        if constexpr (ALIGN_EPI) { if (wr == 1) PG8_BAR; }
    }
    PG8_WAIT_V(0);
    if constexpr (!ALIGN_EPI) { if (wr == 0) PG8_BAR; }
    PG8_BAR;
    if constexpr (Epi::AFTER_DRAIN) { E.fused(acc, cur, wr, wc, fr, fq, lds, wid, lane); S.done(cur); }
#undef PG8_SA
#undef PG8_SB
#undef PG8_STAGE
#undef PG8_LDA
#undef PG8_LDB
#undef PG8_MMA
#undef PG8_WAIT_V
#undef PG8_WAIT_L
#undef PG8_BAR
#undef PG8_SCHED
}
}
typedef float cvt_f32x2_t __attribute__((ext_vector_type(2))); typedef __bf16 cvt_bf16x2_t __attribute__((ext_vector_type(2)));
__device__ __forceinline__ unsigned cvt_pk_bf16(float lo, float hi) { cvt_f32x2_t v = {lo, hi}; cvt_bf16x2_t b = __builtin_convertvector(v, cvt_bf16x2_t); return __builtin_bit_cast(unsigned, b); }

#define LAS __attribute__((address_space(3)))
typedef unsigned short bf16;
typedef float f32x4 __attribute__((ext_vector_type(4)));
typedef float f32x2 __attribute__((ext_vector_type(2)));
typedef float f32x16 __attribute__((ext_vector_type(16)));
typedef unsigned u32x4 __attribute__((ext_vector_type(4)));
typedef unsigned u32x2 __attribute__((ext_vector_type(2)));
typedef short bf16x8 __attribute__((ext_vector_type(8)));

constexpr int MP = 32768, MS = 2048, MT = MP + MS, DM = 1024, DIN = 5632, NMAIN = 5376, DFF = 2816, SEQ = 8192;
constexpr int NCHUNK = MT / 64;
constexpr float RMS_EPS = 1e-6f;
constexpr float LOG2E = 1.4426950408889634f;
constexpr float QSCALE = 0.18033688011112042f;
constexpr size_t MiB = 1u << 20;
constexpr size_t WS_RSTD1 = 64 * 1024, WS_SS2 = 256 * 1024, WS_SS3 = 448 * 1024;
constexpr size_t WS_ROPE = 1 * MiB;
constexpr size_t WS_CTA = 2 * MiB, WS_CTH = 4 * MiB + 256 * 1024, WS_HP = 6 * MiB + 512 * 1024;
constexpr size_t WS_FU = 9 * MiB, WS_HU = 15 * MiB;
constexpr size_t WS_GW = 21 * MiB, WS_WIN = 22 * MiB, WS_WUP = 33 * MiB, WS_WDN = 44 * MiB, WS_WOUT = 50 * MiB;
constexpr size_t WS_KS = 52 * MiB, WS_VTS = 55 * MiB, WS_K = 58 * MiB, WS_VT = 74 * MiB;
constexpr size_t WS_B0 = 90 * MiB, WS_XR = 158 * MiB, WS_GG = 226 * MiB, WS_Q = 294 * MiB, WS_GA = 362 * MiB, WS_AC = 430 * MiB, WS_END = 498 * MiB;
constexpr size_t WS_HID = WS_GG;
constexpr size_t O_Y = 0, O_KP = 35651584, O_VP = 35782656, O_HP = 35913728, O_LCP = 35917824, O_FCP = 35930112,
                 O_KS = 35975168, O_VS = 37023744, O_HS = 38072320, O_LCS = 38105088, O_FCS = 38203392, O_END = 38563840;
constexpr int LDS_BYTES = 163840, LDS_EX = 131072, LDS_MISC = 139264;

__device__ __forceinline__ float bf_lo(unsigned w) { return __builtin_bit_cast(float, w << 16); }
__device__ __forceinline__ float bf_hi(unsigned w) { return __builtin_bit_cast(float, w & 0xffff0000u); }
__device__ __forceinline__ float bf1(bf16 h) { return __builtin_bit_cast(float, (unsigned)h << 16); }
__device__ __forceinline__ bf16 f2bf(float f) { return (bf16)(cvt_pk_bf16(f, 0.f) & 0xffffu); }
__device__ __forceinline__ void unpack8(u32x4 w, float* f) { f[0] = bf_lo(w.x); f[1] = bf_hi(w.x); f[2] = bf_lo(w.y); f[3] = bf_hi(w.y); f[4] = bf_lo(w.z); f[5] = bf_hi(w.z); f[6] = bf_lo(w.w); f[7] = bf_hi(w.w); }
__device__ __forceinline__ u32x4 pack8(const float* f) { u32x4 w; w.x = cvt_pk_bf16(f[0], f[1]); w.y = cvt_pk_bf16(f[2], f[3]); w.z = cvt_pk_bf16(f[4], f[5]); w.w = cvt_pk_bf16(f[6], f[7]); return w; }
__device__ __forceinline__ float sigmoidf_(float x) { return __builtin_amdgcn_rcpf(1.f + __builtin_amdgcn_exp2f(-LOG2E * x)); }
__device__ __forceinline__ void sigmoid2(float x0, float x1, float& s0, float& s1) {
    const float a = 1.f + __builtin_amdgcn_exp2f(fminf(-LOG2E * x0, 60.f)), b = 1.f + __builtin_amdgcn_exp2f(fminf(-LOG2E * x1, 60.f)), r = __builtin_amdgcn_rcpf(a * b);
    s0 = b * r; s1 = a * r;
}
template <int N> __device__ __forceinline__ float dpp_ror(float v) { return __builtin_bit_cast(float, __builtin_amdgcn_update_dpp(0, __builtin_bit_cast(int, v), 0x120 + N, 0xf, 0xf, false)); }
__device__ __forceinline__ float gelu_tanh(float x) { const float z = 1.5957691216057308f * (x + 0.044715f * x * x * x); return x * sigmoidf_(z); }
__device__ __forceinline__ int crow(int r, int hi) { return (r & 3) + 8 * (r >> 2) + 4 * hi; }
__device__ __forceinline__ float wave_sum(float v) {
#pragma unroll
    for (int o = 1; o < 64; o <<= 1) v += __shfl_xor(v, o);
    return v;
}

struct Ctx {
    const float* in[24]; float* out; unsigned char* ws;
    int tid, lane, wave, G, bid;
};
__device__ __forceinline__ const float* xrow(const Ctx& C, int r) { return r < MP ? C.in[0] + (size_t)r * DM : C.in[1] + (size_t)(r - MP) * DM; }
__device__ __forceinline__ int pos_of_row(int r) { return r < MP ? (r & (SEQ - 1)) : 1024 + ((r - MP) & 63); }

__device__ __forceinline__ void tr_item(const float* W, int ldn, int ncol0, int k0, bf16* WT, int Kd, int drow0, const float* g, LAS float* scr, int lane) {
    float wv[32];
#pragma unroll
    for (int i = 0; i < 32; ++i) wv[i] = W[(size_t)(k0 + 2 * i + (lane >> 5)) * ldn + ncol0 + (lane & 31)];
#pragma unroll
    for (int i = 0; i < 32; ++i) { const int kk = 2 * i + (lane >> 5); float v = wv[i]; if (g) v *= g[k0 + kk]; scr[kk * 33 + (lane & 31)] = v; }
    asm volatile("s_waitcnt lgkmcnt(0)" ::: "memory");
    const int c = lane & 7;
#pragma unroll
    for (int j = 0; j < 4; ++j) { const int n = (lane >> 3) + 8 * j; const LAS float* s = scr + (8 * c) * 33 + n;
        u32x4 o; o.x = cvt_pk_bf16(s[0 * 33], s[1 * 33]); o.y = cvt_pk_bf16(s[2 * 33], s[3 * 33]); o.z = cvt_pk_bf16(s[4 * 33], s[5 * 33]); o.w = cvt_pk_bf16(s[6 * 33], s[7 * 33]);
        *(u32x4*)(WT + (size_t)(drow0 + n) * Kd + k0 + 8 * c) = o; }
    asm volatile("s_waitcnt lgkmcnt(0)" ::: "memory");
}
__device__ __forceinline__ int win_src_col(int d) {
    if (d < 1024) return d;
    if (d < 3072) { const int j = (d - 1024) >> 8, o = (d - 1024) & 255; return o < 128 ? 1024 + 128 * j + o : 3584 + 128 * j + (o - 128); }
    if (d < 4096) return 2048 + (d - 3072);
    if (d < 4352) return 3072 + (d - 4096);
    if (d < 5376) return 4608 + (d - 4352);
    return 3328 + (d - 5376);
}
__device__ __forceinline__ void sincos_d(double a, float& s, float& c) {
    const double k = rint(a * 0.6366197723675814);
    double r = fma(-k, 1.5707963267948966, a); r = fma(-k, 6.123233995736766e-17, r);
    const int q = ((int)k) & 3; const double r2 = r * r;
    const double sp = r * (1.0 + r2 * (-1.0 / 6 + r2 * (1.0 / 120 + r2 * (-1.0 / 5040 + r2 * (1.0 / 362880 + r2 * (-1.0 / 39916800))))));
    const double cp = 1.0 + r2 * (-0.5 + r2 * (1.0 / 24 + r2 * (-1.0 / 720 + r2 * (1.0 / 40320 + r2 * (-1.0 / 3628800 + r2 * (1.0 / 479001600))))));
    const double ss = (q == 0) ? sp : (q == 1) ? cp : (q == 2) ? -sp : -cp;
    const double cc = (q == 0) ? cp : (q == 1) ? -sp : (q == 2) ? -cp : sp;
    s = (float)ss; c = (float)cc;
}
__device__ __forceinline__ void p0_prologue(const Ctx& C, LAS unsigned char* lds) {
    unsigned char* ws = C.ws;
    LAS float* scr = (LAS float*)(lds + C.wave * 16384);
    const int gw = C.bid * 8 + C.wave, NGW = C.G * 8, gt = C.bid * 512 + C.tid, GT = C.G * 512;
    constexpr int I_IN = (DIN / 32) * 16, I_UP = (DIN / 32) * 16, I_OUT = 32 * 16, I_DN = 32 * 44;
    for (int it = gw; it < I_IN + I_UP + I_OUT + I_DN; it += NGW) {
        int r = it;
        if (r < I_IN) { const int rg = r >> 4, kb = r & 15; tr_item(C.in[8], DIN, win_src_col(32 * rg), 64 * kb, (bf16*)(ws + WS_WIN), DM, 32 * rg, C.in[7], scr, C.lane); continue; } r -= I_IN;
        if (r < I_UP) { const int rg = r >> 4, kb = r & 15, d = 32 * rg, pn = d >> 8, o = d & 255; const int src = o < 128 ? 128 * pn + o : DFF + 128 * pn + (o - 128);
                        tr_item(C.in[19], DIN, src, 64 * kb, (bf16*)(ws + WS_WUP), DM, d, C.in[18], scr, C.lane); continue; } r -= I_UP;
        if (r < I_OUT) { const int rg = r >> 4, kb = r & 15; tr_item(C.in[17], DM, 32 * rg, 64 * kb, (bf16*)(ws + WS_WOUT), DM, 32 * rg, nullptr, scr, C.lane); continue; } r -= I_OUT;
        { const int rg = r / 44, kb = r % 44; tr_item(C.in[22], DM, 32 * rg, 64 * kb, (bf16*)(ws + WS_WDN), DFF, 32 * rg, nullptr, scr, C.lane); }
    }
    { bf16* GW = (bf16*)(ws + WS_GW);
      for (int e = gt; e < 2 * 16 * 64 * 64; e += GT) { const int c = e & 63, d = (e >> 6) & 63, nb = (e >> 12) & 15, g = e >> 16;
          const float* W = g ? C.in[13] : C.in[11]; GW[e] = f2bf(W[(nb * 64 + c) * 64 + d]); } }
    { float* rope = (float*)(ws + WS_ROPE);
      const double INVF[8] = {1.0, 0.1939227447486858, 0.03760603093086394, 0.007292664737217109, 0.0014142135623730955, 0.00027424817567620724, 5.318295896944988e-05, 1.0313385377212461e-05};
      for (int e = gt; e < SEQ * 8; e += GT) { const int pos = e >> 3, j = e & 7;
          const double f = (j == 0) ? INVF[0] : (j == 1) ? INVF[1] : (j == 2) ? INVF[2] : (j == 3) ? INVF[3] : (j == 4) ? INVF[4] : (j == 5) ? INVF[5] : (j == 6) ? INVF[6] : INVF[7];
          float s, c; sincos_d((double)pos * f, s, c); rope[pos * 16 + j] = c; rope[pos * 16 + 8 + j] = s; } }
    { bf16* XB = (bf16*)(ws + WS_B0); float* rstd1 = (float*)(ws + WS_RSTD1);
      for (int m0 = gw * 4; m0 < MT; m0 += NGW * 4) {
          f32x4 v[4][4];
#pragma unroll
          for (int r = 0; r < 4; ++r) { const f32x4* xr = (const f32x4*)xrow(C, m0 + r) + C.lane;
#pragma unroll
              for (int j = 0; j < 4; ++j) v[r][j] = xr[64 * j]; }
#pragma unroll
          for (int r = 0; r < 4; ++r) { float s = 0.f;
#pragma unroll
              for (int j = 0; j < 4; ++j) s += (v[r][j].x * v[r][j].x + v[r][j].y * v[r][j].y) + (v[r][j].z * v[r][j].z + v[r][j].w * v[r][j].w);
              s = wave_sum(s);
              if (C.lane == 0) rstd1[m0 + r] = 1.0f / sqrtf(s * (1.0f / DM) + RMS_EPS);
              u32x2* o8 = (u32x2*)(XB + (size_t)(m0 + r) * DM) + C.lane;
#pragma unroll
              for (int j = 0; j < 4; ++j) { u32x2 w; w.x = cvt_pk_bf16(v[r][j].x, v[r][j].y); w.y = cvt_pk_bf16(v[r][j].z, v[r][j].w); o8[64 * j] = w; } } } }
    { bf16* KS = (bf16*)(ws + WS_KS); bf16* VTS = (bf16*)(ws + WS_VTS); const float* ck = C.in[2]; const float* cv = C.in[3];
      for (int e = gt; e < 32 * 128 * 32; e += GT) { const int c8 = (e & 31) * 8, r = (e >> 5) & 127, b = e >> 12;
          const f32x4* s = (const f32x4*)(ck + ((size_t)(b * 128 + r) * 256 + c8)); const f32x4 a0 = s[0], a1 = s[1];
          u32x4 w; w.x = cvt_pk_bf16(a0.x, a0.y); w.y = cvt_pk_bf16(a0.z, a0.w); w.z = cvt_pk_bf16(a1.x, a1.y); w.w = cvt_pk_bf16(a1.z, a1.w);
          *(u32x4*)(KS + ((size_t)(b * 192 + r) * 256 + c8)) = w; }
      for (int e = gt; e < 32 * 16 * 256; e += GT) { const int col = e & 255, r8 = (e >> 8) & 15, b = e >> 12; float f[8];
#pragma unroll
          for (int i = 0; i < 8; ++i) f[i] = cv[(size_t)(b * 128 + r8 * 8 + i) * 256 + col];
          *(u32x4*)(VTS + ((size_t)(b * 256 + col) * 192 + r8 * 8)) = pack8(f); }
      float* oks = C.out + O_KS; float* ovs = C.out + O_VS;
      for (int e = gt; e < 32 * 64 * 64; e += GT) { const int c4 = (e & 63) * 4, r = (e >> 6) & 63, b = e >> 12;
          *(f32x4*)(oks + ((size_t)(b * 128 + r) * 256 + c4)) = *(const f32x4*)(ck + ((size_t)(b * 128 + 64 + r) * 256 + c4));
          *(f32x4*)(ovs + ((size_t)(b * 128 + r) * 256 + c4)) = *(const f32x4*)(cv + ((size_t)(b * 128 + 64 + r) * 256 + c4)); } }
    { float* ss2 = (float*)(ws + WS_SS2); float* ss3 = (float*)(ws + WS_SS3);
      for (int e = gt; e < MT; e += GT) { ss2[e] = 0.f; ss3[e] = 0.f; } }
}

struct EpiMain {
    static constexpr bool PERM = true, AFTER_DRAIN = false;
    bf16 *XR, *GG, *Q, *Kp, *KS, *GA; const float* rstd1; const float* rope; float *okp, *oks;
#define EM_ROWS_BEGIN _Pragma("unroll") for (int ai = 0; ai < 2; ++ai) _Pragma("unroll") for (int m = 0; m < 4; ++m) { \
        const int row = u.pm * 256 + ai * 128 + wr * 64 + m * 16 + fr; const float rs = rsv[ai * 4 + m]; float v[2][8]; \
        _Pragma("unroll") for (int bj = 0; bj < 2; ++bj) _Pragma("unroll") for (int n = 0; n < 2; ++n) _Pragma("unroll") for (int e = 0; e < 4; ++e) v[bj][4 * n + e] = acc[ai][bj][m][n][e] * rs;
#define EM_ROWS_END asm volatile("" ::: "memory"); }
    __device__ __forceinline__ void operator()(pg8::f32x4 (&acc)[2][2][4][2], const pg8::Unit& u, int wr, int wc, int fr, int fq) const {
        const int pn = u.pn; int cw = wc * 32 + 8 * fq;
        float rsv[8];
#pragma unroll
        for (int i = 0; i < 8; ++i) rsv[i] = rstd1[u.pm * 256 + (i >> 2) * 128 + wr * 64 + (i & 3) * 16 + fr];
        asm volatile("" : "+v"(cw));
        if (pn < 4) {
            EM_ROWS_BEGIN
#pragma unroll
                for (int bj = 0; bj < 2; ++bj) *(u32x4*)(XR + (size_t)row * DM + pn * 256 + bj * 128 + cw) = pack8(v[bj]);
            EM_ROWS_END
        } else if (pn < 12) {
            EM_ROWS_BEGIN
                float g[8];
#pragma unroll
                for (int i = 0; i < 8; ++i) { const float y = v[0][i], z = 1.5957691216057308f * (y + 0.044715f * y * y * y);
                    const float e1 = 1.f + __builtin_amdgcn_exp2f(fminf(-LOG2E * z, 60.f)), e2 = 1.f + __builtin_amdgcn_exp2f(fminf(-LOG2E * v[1][i], 60.f));
                    g[i] = y * __builtin_amdgcn_rcpf(e1 * e2); }
                *(u32x4*)(GG + (size_t)row * DM + (pn - 4) * 128 + cw) = pack8(g);
            EM_ROWS_END
        } else if (pn < 17) {
            const bool rot = (wc & 1) == 0;
            EM_ROWS_BEGIN
                const int pos = pos_of_row(row);
                const f32x4* rp = (const f32x4*)(rope + pos * 16);
                const f32x4 c0 = rp[0], c1 = rp[1], s0 = rp[2], s1 = rp[3];
                const float cs[8] = {c0.x, c0.y, c0.z, c0.w, c1.x, c1.y, c1.z, c1.w}, sn[8] = {s0.x, s0.y, s0.z, s0.w, s1.x, s1.y, s1.z, s1.w};
#pragma unroll
                for (int bj = 0; bj < 2; ++bj)
#pragma unroll
                    for (int i = 0; i < 8; ++i) {
                        const float mine = v[bj][i], other = __shfl_xor(mine, 16);
                        const float r0 = mine * cs[i] - other * sn[i], r1 = mine * cs[i] + other * sn[i];
                        v[bj][i] = (rot && fq == 0) ? r0 : (rot && fq == 1) ? r1 : mine;
                    }
                if (pn < 16) {
#pragma unroll
                    for (int bj = 0; bj < 2; ++bj) { float q[8];
#pragma unroll
                        for (int i = 0; i < 8; ++i) q[i] = v[bj][i] * QSCALE;
                        *(u32x4*)(Q + (size_t)row * DM + (pn - 12) * 256 + bj * 128 + cw) = pack8(q); }
                } else if (u.pm < 128) {
#pragma unroll
                    for (int bj = 0; bj < 2; ++bj) *(u32x4*)(Kp + (size_t)row * 256 + bj * 128 + cw) = pack8(v[bj]);
                    if ((u.pm & 31) == 31 && ai == 1) { const int b = u.pm >> 5, tt = wr * 64 + m * 16 + fr;
#pragma unroll
                        for (int bj = 0; bj < 2; ++bj) { float* o = okp + ((size_t)(b * 128 + tt) * 256 + bj * 128 + cw);
                            *(f32x4*)o = (f32x4){v[bj][0], v[bj][1], v[bj][2], v[bj][3]}; *(f32x4*)(o + 4) = (f32x4){v[bj][4], v[bj][5], v[bj][6], v[bj][7]}; } }
                } else {
                    const int rr = row - MP, sb = rr >> 6, t = rr & 63;
#pragma unroll
                    for (int bj = 0; bj < 2; ++bj) { *(u32x4*)(KS + ((size_t)(sb * 192 + 128 + t) * 256 + bj * 128 + cw)) = pack8(v[bj]);
                        float* o = oks + ((size_t)(sb * 128 + 64 + t) * 256 + bj * 128 + cw);
                        *(f32x4*)o = (f32x4){v[bj][0], v[bj][1], v[bj][2], v[bj][3]}; *(f32x4*)(o + 4) = (f32x4){v[bj][4], v[bj][5], v[bj][6], v[bj][7]}; }
                }
            EM_ROWS_END
        } else {
            EM_ROWS_BEGIN
#pragma unroll
                for (int bj = 0; bj < 2; ++bj) { float g[8];
#pragma unroll
                    for (int i = 0; i < 8; i += 2) sigmoid2(v[bj][i], v[bj][i + 1], g[i], g[i + 1]);
                    *(u32x4*)(GA + (size_t)row * DM + (pn - 17) * 256 + bj * 128 + cw) = pack8(g); }
            EM_ROWS_END
        }
    }
#undef EM_ROWS_BEGIN
#undef EM_ROWS_END
};
struct EpiVt {
    static constexpr bool PERM = true, AFTER_DRAIN = false;
    bf16 *Vt, *VTS; const float* rstd1; float *ovp, *ovs;
    __device__ __forceinline__ void operator()(pg8::f32x4 (&acc)[2][2][4][2], const pg8::Unit& u, int wr, int wc, int fr, int fq) const {
        const bool smp = u.pn >= 128, keep = (u.pn & 31) == 31;
#pragma unroll
        for (int bj = 0; bj < 2; ++bj) {
            const int tok0 = u.pn * 256 + bj * 128 + wc * 32 + 8 * fq;
            const f32x4 r0 = *(const f32x4*)(rstd1 + tok0), r1 = *(const f32x4*)(rstd1 + tok0 + 4);
            const float rs[8] = {r0.x, r0.y, r0.z, r0.w, r1.x, r1.y, r1.z, r1.w};
            const int rr = tok0 - MP, sb = rr >> 6, t = rr & 63;
            bf16* dst = smp ? VTS + ((size_t)(sb * 256) * 192 + 128 + t) : Vt + tok0; const size_t dstride = smp ? 192 : MP;
            float* kp = smp ? ovs + (size_t)(sb * 128 + 64 + t) * 256 : ovp + (size_t)((u.pn >> 5) * 128 + wc * 32 + 8 * fq) * 256;
            const bool kflag = smp || (keep && bj == 1);
#pragma unroll
            for (int ai = 0; ai < 2; ++ai)
#pragma unroll
                for (int m = 0; m < 4; ++m) {
                    const int vcol = ai * 128 + wr * 64 + m * 16 + fr; float v[8];
#pragma unroll
                    for (int n = 0; n < 2; ++n)
#pragma unroll
                        for (int e = 0; e < 4; ++e) v[4 * n + e] = acc[ai][bj][m][n][e] * rs[4 * n + e];
                    *(u32x4*)(dst + (size_t)vcol * dstride) = pack8(v);
                    if (kflag) {
#pragma unroll
                        for (int i = 0; i < 8; ++i) kp[i * 256 + vcol] = v[i]; }
                    asm volatile("" ::: "memory");
                }
        }
    }
};
struct EpiWout {
    static constexpr bool PERM = false, AFTER_DRAIN = false;
    const float *xp, *xs; bf16* X1B; float* ss2;
    __device__ __forceinline__ void operator()(pg8::f32x4 (&acc)[2][2][4][2], const pg8::Unit& u, int wr, int wc, int fr, int fq) const {
        int cb = u.pn * 256 + wc * 32 + 4 * fq; asm volatile("" : "+v"(cb));
#pragma unroll
        for (int ai = 0; ai < 2; ++ai) {
            f32x4 xv[4][2][2];
#pragma unroll
            for (int m = 0; m < 4; ++m) { const int row = u.pm * 256 + ai * 128 + wr * 64 + m * 16 + fr;
                const float* xr = row < MP ? xp + (size_t)row * DM : xs + (size_t)(row - MP) * DM;
#pragma unroll
                for (int bj = 0; bj < 2; ++bj)
#pragma unroll
                    for (int n = 0; n < 2; ++n) xv[m][bj][n] = *(const f32x4*)(xr + cb + bj * 128 + 16 * n); }
#pragma unroll
            for (int m = 0; m < 4; ++m) { const int row = u.pm * 256 + ai * 128 + wr * 64 + m * 16 + fr; float s = 0.f;
#pragma unroll
                for (int bj = 0; bj < 2; ++bj)
#pragma unroll
                    for (int n = 0; n < 2; ++n) { const f32x4 y = xv[m][bj][n] + acc[ai][bj][m][n];
                        s += (y.x * y.x + y.y * y.y) + (y.z * y.z + y.w * y.w);
                        u32x2 w; w.x = cvt_pk_bf16(y.x, y.y); w.y = cvt_pk_bf16(y.z, y.w); *(u32x2*)(X1B + (size_t)row * DM + cb + bj * 128 + 16 * n) = w; }
                s += __shfl_xor(s, 16); s += __shfl_xor(s, 32);
                if (fq == 0) unsafeAtomicAdd(ss2 + row, s); }
            asm volatile("" ::: "memory");
        }
    }
};
struct EpiDown {
    static constexpr bool PERM = false, AFTER_DRAIN = false;
    const bf16* X1B; float* Y; float* ss3;
    __device__ __forceinline__ void operator()(pg8::f32x4 (&acc)[2][2][4][2], const pg8::Unit& u, int wr, int wc, int fr, int fq) const {
        int cb = u.pn * 256 + wc * 32 + 4 * fq; asm volatile("" : "+v"(cb));
        u32x2 xb[2][4][2][2];
#pragma unroll
        for (int ai = 0; ai < 2; ++ai)
#pragma unroll
            for (int m = 0; m < 4; ++m) { const size_t ro = (size_t)(u.pm * 256 + ai * 128 + wr * 64 + m * 16 + fr) * DM;
#pragma unroll
                for (int bj = 0; bj < 2; ++bj)
#pragma unroll
                    for (int n = 0; n < 2; ++n) xb[ai][m][bj][n] = X1B ? *(const u32x2*)(X1B + ro + cb + bj * 128 + 16 * n) : (u32x2){0u, 0u}; }
#pragma unroll
        for (int ai = 0; ai < 2; ++ai)
#pragma unroll
            for (int m = 0; m < 4; ++m) { const size_t ro = (size_t)(u.pm * 256 + ai * 128 + wr * 64 + m * 16 + fr) * DM;
#pragma unroll
                for (int bj = 0; bj < 2; ++bj)
#pragma unroll
                    for (int n = 0; n < 2; ++n) { const u32x2 x = xb[ai][m][bj][n];
                        *(f32x4*)(Y + ro + cb + bj * 128 + 16 * n) = (f32x4){bf_lo(x.x), bf_hi(x.x), bf_lo(x.y), bf_hi(x.y)} + acc[ai][bj][m][n]; } }
    }
};
struct EpiUp {
    static constexpr bool PERM = true, AFTER_DRAIN = false;
    bf16* HID; const float* ss2; const float* cw; const float* cb; const float* fstate; float *FU, *HU, *ofcp, *ofcs; LAS unsigned char* ex;
    __device__ __forceinline__ void operator()(pg8::f32x4 (&acc)[2][2][4][2], const pg8::Unit& u, int wr, int wc, int fr, int fq) const {
        const int pm = u.pm, pn = u.pn, lane = threadIdx.x & 63; const bool smp = pm >= 128;
        const int cw8 = wc * 32 + 8 * fq;
#pragma unroll
        for (int ai = 0; ai < 2; ++ai)
#pragma unroll
            for (int m = 0; m < 4; ++m) { const int row = pm * 256 + ai * 128 + wr * 64 + m * 16 + fr; const float rs = __builtin_amdgcn_rsqf(ss2[row] * (1.0f / DM) + RMS_EPS);
#pragma unroll
                for (int bj = 0; bj < 2; ++bj)
#pragma unroll
                    for (int n = 0; n < 2; ++n) acc[ai][bj][m][n] = acc[ai][bj][m][n] * rs; }
        LAS float* EX = (LAS float*)ex;
        if (fr >= 14) {
#pragma unroll
            for (int ai = 0; ai < 2; ++ai)
#pragma unroll
                for (int bj = 0; bj < 2; ++bj)
#pragma unroll
                    for (int n = 0; n < 2; ++n) {
                        const f32x4 v = acc[ai][bj][3][n]; const int srccol = bj * DFF + pn * 128 + cw8 + 4 * n, cl = bj * 128 + cw8 + 4 * n;
                        *(LAS f32x4*)(EX + ((ai * 2 + wr) * 2 + (fr - 14)) * 256 + cl) = v;
                        if (smp) { const int st = 4 * (pm - 128) + 2 * ai + wr; *(f32x4*)(ofcs + (size_t)(st * 2 + fr - 14) * DIN + srccol) = v; }
                        else if (ai == 1 && wr == 1) { *(f32x4*)(HU + (size_t)(pm * 2 + fr - 14) * DIN + pn * 256 + cl) = v;
                            if ((pm & 31) == 31) *(f32x4*)(ofcp + (size_t)((pm >> 5) * 2 + fr - 14) * DIN + srccol) = v; }
                    }
        }
        if (!smp && fr < 2 && wr == 0) {
#pragma unroll
            for (int bj = 0; bj < 2; ++bj)
#pragma unroll
                for (int n = 0; n < 2; ++n) *(f32x4*)(FU + (size_t)(pm * 2 + fr) * DIN + pn * 256 + bj * 128 + cw8 + 4 * n) = acc[0][bj][0][n];
        }
        asm volatile("s_waitcnt lgkmcnt(0)" ::: "memory"); __builtin_amdgcn_s_barrier(); asm volatile("" ::: "memory");
#pragma unroll
        for (int bj = 0; bj < 2; ++bj)
#pragma unroll
            for (int n = 0; n < 2; ++n) {
                const int srccol = bj * DFF + pn * 128 + cw8 + 4 * n, cl = bj * 128 + cw8 + 4 * n;
                const f32x4 w0 = *(const f32x4*)(cw + srccol), w1 = *(const f32x4*)(cw + DIN + srccol), w2 = *(const f32x4*)(cw + 2 * DIN + srccol), bb = *(const f32x4*)(cb + srccol);
#pragma unroll
                for (int ai = 0; ai < 2; ++ai) {
                    const int st = smp ? 4 * (pm - 128) + 2 * ai + wr : 0, hr = fr >= 14 ? fr - 14 : 0;
                    const f32x4 hvF = *(const f32x4*)(fstate + (size_t)(st * 2 + hr) * DIN + srccol);
                    const int exb = (wr == 1) ? ai * 2 : 1;
                    const f32x4 hvE = *(const LAS f32x4*)(EX + (exb * 2 + hr) * 256 + cl);
                    const bool useE = !smp && (wr == 1 || ai == 1);
                    f32x4 hv;
#pragma unroll
                    for (int e = 0; e < 4; ++e) hv[e] = smp ? hvF[e] : (useE ? hvE[e] : 0.f);
#pragma unroll
                    for (int e = 0; e < 4; ++e) {
                        float c1 = dpp_ror<1>(acc[ai][bj][3][n][e]), c2 = dpp_ror<2>(acc[ai][bj][3][n][e]);
#pragma unroll
                        for (int m = 3; m >= 0; --m) {
                            const float pv = (m > 0) ? acc[ai][bj][m > 0 ? m - 1 : 0][n][e] : hv[e];
                            const float q1 = dpp_ror<1>(pv), q2 = dpp_ror<2>(pv);
                            const float p1 = fr >= 1 ? c1 : q1, p2 = fr >= 2 ? c2 : q2;
                            float res = bb[e] + w0[e] * p2 + w1[e] * p1 + w2[e] * acc[ai][bj][m][n][e];
                            asm volatile("" : "+v"(res));
                            acc[ai][bj][m][n][e] = res;
                            c1 = q1; c2 = q2;
                        }
                        __builtin_amdgcn_sched_barrier(0);
                    }
                    asm volatile("" ::: "memory");
                }
            }
#pragma unroll
        for (int ai = 0; ai < 2; ++ai)
#pragma unroll
            for (int m = 0; m < 4; ++m) { const int row = pm * 256 + ai * 128 + wr * 64 + m * 16 + fr; float h[8];
#pragma unroll
                for (int n = 0; n < 2; ++n)
#pragma unroll
                    for (int e = 0; e < 4; e += 2) { const float g0 = acc[ai][0][m][n][e], g1 = acc[ai][0][m][n][e + 1]; float s0, s1; sigmoid2(g0, g1, s0, s1);
                        h[4 * n + e] = g0 * s0 * acc[ai][1][m][n][e]; h[4 * n + e + 1] = g1 * s1 * acc[ai][1][m][n][e + 1]; }
                *(u32x4*)(HID + (size_t)row * DFF + pn * 128 + cw8) = pack8(h); }
    }
};
struct OffsetOrder {
    pg8::StaticOrder S;
    __device__ __forceinline__ void init(int M, int N, int G, int c, int off) { S.init(M, N, G, (c - off + G) % G); }
    __device__ __forceinline__ bool next(int i, pg8::Unit& u) const { return S.next(i, u); }
    __device__ __forceinline__ void a_ready(const pg8::Unit&) const {}
    __device__ __forceinline__ void done(const pg8::Unit&) const {}
};

struct RowOrder {
    pg8::StaticOrder S; int pm0;
    __device__ __forceinline__ void init(int Mrows, int N, int G, int c, int pm0_) { S.init(Mrows, N, G, c); pm0 = pm0_; }
    __device__ __forceinline__ bool next(int i, pg8::Unit& u) const { if (!S.next(i, u)) return false; u.pm += pm0; return true; }
    __device__ __forceinline__ void a_ready(const pg8::Unit&) const {}
    __device__ __forceinline__ void done(const pg8::Unit&) const {}
};

struct P2Ptrs {
    const bf16 *XR, *Q, *Kp, *KS, *Vt, *VTS, *GW; bf16 *H, *AC, *MIX; float *CTA, *CTH; const bf16 *GG, *GA; const float* HP;
    const float *lconv, *cw, *cb, *gab, *gib, *lam, *h0, *sinks; float *olcp, *olcs, *ohs;
};
__device__ __forceinline__ void lru_load_x(const P2Ptrs& P, int unit, int tid, u32x4 (&raw)[5]) {
    const int cgp = unit & 7, cidx = unit >> 3; const bool smp = cidx >= 512; const int row0 = cidx * 64, cib = cidx & 127, co = tid & 15, rg = tid >> 4, chb = 128 * cgp + 8 * co;
#pragma unroll
    for (int k = 0; k < 5; ++k) { const int tr = 2 * rg - 3 + k;
        if (tr >= 0 || (!smp && cib > 0)) raw[k] = *(const u32x4*)(P.XR + (size_t)(row0 + tr) * DM + chb); else raw[k] = (u32x4){0u, 0u, 0u, 0u}; }
}
__device__ __forceinline__ void lru_phase(const P2Ptrs& P, LAS unsigned char* lds, int bid, int G) {
    int tid_ = threadIdx.x; asm volatile("" : "+v"(tid_));
    const int tid = tid_, lane = tid & 63, wid = tid >> 6, l32 = lane & 31, hi = lane >> 5;
    LAS unsigned char* XC = lds;
    LAS f32x2* AU = (LAS f32x2*)(lds + 17408);
    LAS f32x2* SEG = (LAS f32x2*)(lds + 17408 + 65536);
    const int co = tid & 15, rg = tid >> 4, nbl = wid >> 2, rh = (wid >> 1) & 1, chh = wid & 1;
    int cur = -1; float cwt[4][8], cbs[8]; bf16x8 wa[4], wi[4]; float bga = 0.f, bgi = 0.f, c8 = 0.f;
    u32x4 raw[5];
    const int NU = NCHUNK * 8;
    if (bid < NU) lru_load_x(P, bid, tid, raw);
    for (int unit = bid; unit < NU; unit += G) {
        const int cgp = unit & 7, cidx = unit >> 3; const bool smp = cidx >= 512; const int row0 = cidx * 64, cib = cidx & 127, sb = cidx - 512, ch0 = 128 * cgp;
        const int chb = ch0 + 8 * co, chl = 64 * nbl + 32 * chh + l32;
        if (cgp != cur) { cur = cgp;
#pragma unroll
            for (int j = 0; j < 4; ++j) { const f32x4 a0 = *(const f32x4*)(P.cw + j * DM + chb), a1 = *(const f32x4*)(P.cw + j * DM + chb + 4);
                cwt[j][0] = a0.x; cwt[j][1] = a0.y; cwt[j][2] = a0.z; cwt[j][3] = a0.w; cwt[j][4] = a1.x; cwt[j][5] = a1.y; cwt[j][6] = a1.z; cwt[j][7] = a1.w; }
            { const f32x4 a0 = *(const f32x4*)(P.cb + chb), a1 = *(const f32x4*)(P.cb + chb + 4);
              cbs[0] = a0.x; cbs[1] = a0.y; cbs[2] = a0.z; cbs[3] = a0.w; cbs[4] = a1.x; cbs[5] = a1.y; cbs[6] = a1.z; cbs[7] = a1.w; }
            const int nb = 2 * cgp + nbl;
#pragma unroll
            for (int s4 = 0; s4 < 4; ++s4) { wa[s4] = *(const bf16x8*)(P.GW + ((size_t)((0 * 16 + nb) * 64 + 32 * chh + l32) * 64 + 16 * s4 + 8 * hi));
                wi[s4] = *(const bf16x8*)(P.GW + ((size_t)((1 * 16 + nb) * 64 + 32 * chh + l32) * 64 + 16 * s4 + 8 * hi)); }
            const int ch = ch0 + chl; bga = P.gab[ch]; bgi = P.gib[ch]; const float z = -P.lam[ch];
            c8 = 8.0f * (fmaxf(z, 0.f) + log1pf(__expf(-fabsf(z)))); }
        const float nbga = -LOG2E * bga, nbgi = -LOG2E * bgi;
        { float xv[5][8];
#pragma unroll
          for (int k = 0; k < 5; ++k) unpack8(raw[k], xv[k]);
          if (smp && rg < 2) {
#pragma unroll
              for (int k = 0; k < 3; ++k) { const int tr = 2 * rg - 3 + k;
                  if (tr < 0) { const float* sp = P.lconv + (size_t)(sb * 3 + 3 + tr) * DM + chb; const f32x4 a0 = *(const f32x4*)sp, a1 = *(const f32x4*)(sp + 4);
                      xv[k][0] = a0.x; xv[k][1] = a0.y; xv[k][2] = a0.z; xv[k][3] = a0.w; xv[k][4] = a1.x; xv[k][5] = a1.y; xv[k][6] = a1.z; xv[k][7] = a1.w; } } }
          if (unit + G < NU) lru_load_x(P, unit + G, tid, raw);
          float y0[8], y1[8];
#pragma unroll
          for (int e = 0; e < 8; ++e) {
              y0[e] = cbs[e] + cwt[0][e] * xv[0][e] + cwt[1][e] * xv[1][e] + cwt[2][e] * xv[2][e] + cwt[3][e] * xv[3][e];
              y1[e] = cbs[e] + cwt[0][e] * xv[1][e] + cwt[1][e] * xv[2][e] + cwt[2][e] * xv[3][e] + cwt[3][e] * xv[4][e]; }
          *(LAS u32x4*)(XC + (2 * rg) * 272 + co * 16) = pack8(y0);
          *(LAS u32x4*)(XC + (2 * rg + 1) * 272 + co * 16) = pack8(y1);
          if (rg == 31 && (smp || cib == 127)) { float* o = smp ? P.olcs + (size_t)sb * 3 * DM : P.olcp + (size_t)(cidx >> 7) * 3 * DM;
#pragma unroll
              for (int j = 0; j < 3; ++j) { *(f32x4*)(o + j * DM + chb) = (f32x4){xv[2 + j][0], xv[2 + j][1], xv[2 + j][2], xv[2 + j][3]}; *(f32x4*)(o + j * DM + chb + 4) = (f32x4){xv[2 + j][4], xv[2 + j][5], xv[2 + j][6], xv[2 + j][7]}; } }
        }
        __syncthreads();
        { f32x16 ga = {}, gi = {};
#pragma unroll
          for (int s4 = 0; s4 < 4; ++s4) {
              const bf16x8 a = *(const LAS bf16x8*)(XC + (32 * rh + l32) * 272 + (64 * nbl + 16 * s4 + 8 * hi) * 2);
              ga = __builtin_amdgcn_mfma_f32_32x32x16_bf16(a, wa[s4], ga, 0, 0, 0);
              gi = __builtin_amdgcn_mfma_f32_32x32x16_bf16(a, wi[s4], gi, 0, 0, 0);
          }
#pragma unroll
          for (int r = 0; r < 16; ++r) { const int t = 32 * rh + crow(r, hi);
              const float xc = bf1(*(const LAS bf16*)(XC + t * 272 + chl * 2));
              const float ea = 1.f + __builtin_amdgcn_exp2f(fminf(__builtin_fmaf(ga[r], -LOG2E, nbga), 60.f)), ei = 1.f + __builtin_amdgcn_exp2f(fminf(__builtin_fmaf(gi[r], -LOG2E, nbgi), 60.f));
              const float rp = __builtin_amdgcn_rcpf(ea * ei), rr = ei * rp, ii = ea * rp, la = -c8 * rr;
              float e1 = la * (1.f + la * (0.5f + la * (1.f / 6 + la * (1.f / 24 + la * (1.f / 120 + la * (1.f / 720))))));
              if (__builtin_expect(la < -0.3f, 0)) e1 = __builtin_amdgcn_exp2f(la * LOG2E) - 1.f;
              const float a = 1.f + e1;
              const float uu = __builtin_amdgcn_sqrtf(fmaxf(-e1 * (2.f + e1), 0.f)) * ii * xc;
              AU[t * 128 + chl] = (f32x2){a, uu}; }
        }
        __syncthreads();
        { const int seg = tid >> 7, chs = tid & 127, ch = ch0 + chs; float hl[16], Al[16]; float h = 0.f, A = 1.f;
#pragma unroll
          for (int i = 0; i < 16; ++i) { const f32x2 au = AU[(16 * seg + i) * 128 + chs]; h = au.x * h + au.y; A *= au.x; hl[i] = h; Al[i] = A; }
          SEG[seg * 128 + chs] = (f32x2){A, h};
          __syncthreads();
          float cin = smp ? P.h0[(size_t)sb * DM + ch] : 0.f, Ain = 1.f;
#pragma unroll
          for (int s4 = 0; s4 < 3; ++s4) if (s4 < seg) { const f32x2 t = SEG[s4 * 128 + chs]; cin = t.x * cin + t.y; Ain *= t.x; }
#pragma unroll
          for (int i = 0; i < 16; ++i) { const size_t o = (size_t)(row0 + 16 * seg + i) * DM + ch; P.H[o] = f2bf(hl[i] + Al[i] * cin); P.AC[o] = f2bf(Al[i] * Ain); }
          if (seg == 3) { const float hf = hl[15] + Al[15] * cin; P.CTA[(size_t)cidx * DM + ch] = Al[15] * Ain; P.CTH[(size_t)cidx * DM + ch] = hf; if (smp) P.ohs[(size_t)sb * DM + ch] = hf; }
        }
        __syncthreads();
    }
}
struct AttnGeom { int tile0, qrow0, kvh, bc; bool smp; const bf16* kbase; const bf16* vbase; size_t vstride; };
__device__ __forceinline__ AttnGeom attn_geom(const P2Ptrs& P, int unit) {
    AttnGeom g; g.kvh = unit & 3; g.bc = unit >> 2; g.smp = g.bc >= 512;
    if (!g.smp) { const int b = g.bc >> 7, c = g.bc & 127; g.tile0 = c == 0 ? 4 : (c == 1 ? 2 : 0); const long tok0 = (long)b * SEQ + 64 * (c - 2);
        g.kbase = P.Kp + tok0 * 256 + g.kvh * 64; g.vbase = P.Vt + (size_t)(g.kvh * 64) * MP + tok0; g.vstride = MP; g.qrow0 = b * SEQ + 64 * c; }
    else { const int sb = g.bc - 512; g.tile0 = 0; g.kbase = P.KS + (size_t)(sb * 192) * 256 + g.kvh * 64; g.vbase = P.VTS + (size_t)(sb * 256 + g.kvh * 64) * 192; g.vstride = 192; g.qrow0 = MP + 64 * sb; }
    return g;
}
__device__ __forceinline__ void attn_load(const P2Ptrs& P, const AttnGeom& g, int tid, u32x4 (&kr)[3], u32x4 (&vr)[3], bf16x8 (&qf)[4]) {
    const int lane = tid & 63, wid = tid >> 6, l32 = lane & 31, hi = lane >> 5, key_first = g.tile0 * 32;
#pragma unroll
    for (int j = 0; j < 3; ++j) { const int idx = tid + 512 * j, row = idx >> 3, ch = idx & 7;
        if (row >= key_first) kr[j] = *(const u32x4*)(g.kbase + (long)row * 256 + ch * 8); }
#pragma unroll
    for (int j = 0; j < 3; ++j) { const int idx = tid + 512 * j, d = idx / 24, chk = idx % 24;
        if (chk * 8 >= key_first) vr[j] = *(const u32x4*)(g.vbase + (size_t)d * g.vstride + chk * 8); }
    const int h = g.kvh * 4 + (wid >> 1), qr = g.qrow0 + 32 * (wid & 1);
#pragma unroll
    for (int s = 0; s < 4; ++s) qf[s] = *(const bf16x8*)(P.Q + (size_t)(qr + l32) * DM + h * 64 + 16 * s + 8 * hi);
}
__device__ __forceinline__ void attn_phase(const P2Ptrs& P, LAS unsigned char* lds, int first, int end, int stride) {
    int tid_ = threadIdx.x; asm volatile("" : "+v"(tid_));
    const int tid = tid_, lane = tid & 63, wid = tid >> 6, l32 = lane & 31, hi = lane >> 5, g = wid >> 1;
    LAS unsigned char* Ks = lds;
    LAS unsigned char* Vs = lds + 27648;
    LAS unsigned char* OT = lds + 53248;
    u32x4 kr[3], vr[3]; bf16x8 qn[4];
#pragma unroll
    for (int j = 0; j < 3; ++j) { kr[j] = (u32x4){0u, 0u, 0u, 0u}; vr[j] = (u32x4){0u, 0u, 0u, 0u}; }
    if (first < end) { const AttnGeom G0 = attn_geom(P, first); attn_load(P, G0, tid, kr, vr, qn); }
    for (int unit = first; unit < end; unit += stride) {
        const AttnGeom G = attn_geom(P, unit);
        const int tile0 = G.tile0, key_first = tile0 * 32, kvh = G.kvh, qrow0 = G.qrow0, h = kvh * 4 + g;
#pragma unroll
        for (int j = 0; j < 3; ++j) { const int idx = tid + 512 * j, row = idx >> 3, ch = idx & 7;
            if (row >= key_first) *(LAS u32x4*)(Ks + row * 144 + ch * 16) = kr[j]; }
#pragma unroll
        for (int j = 0; j < 3; ++j) { const int idx = tid + 512 * j, d = idx / 24, chk = idx % 24;
            if (chk * 8 >= key_first) { *(LAS u32x2*)(Vs + d * 392 + chk * 16) = (u32x2){vr[j].x, vr[j].y}; *(LAS u32x2*)(Vs + d * 392 + chk * 16 + 8) = (u32x2){vr[j].z, vr[j].w}; } }
        bf16x8 qf[4];
#pragma unroll
        for (int s = 0; s < 4; ++s) qf[s] = qn[s];
        const float sink2 = P.sinks[h] * LOG2E;
        const int mrow = tid >> 3, mcg = tid & 7; u32x4 mh[4], mac[4], mgg[4], mga[4];
        __syncthreads();
        f32x16 p[6];
#pragma unroll
        for (int kt = 0; kt < 6; ++kt) { p[kt] = (f32x16){};
            if (kt >= tile0) {
#pragma unroll
                for (int s = 0; s < 4; ++s) { const bf16x8 a = *(const LAS bf16x8*)(Ks + (32 * kt + l32) * 144 + (16 * s + 8 * hi) * 2);
                    p[kt] = __builtin_amdgcn_mfma_f32_32x32x16_bf16(a, qf[s], p[kt], 0, 0, 0); } } }
        float mx = -3.0e38f;
#pragma unroll
        for (int kt = 0; kt < 6; ++kt) if (kt >= tile0) {
#pragma unroll
            for (int r = 0; r < 16; ++r) mx = fmaxf(mx, p[kt][r]); }
        mx = fmaxf(mx, __shfl_xor(mx, 32)); mx = fmaxf(mx, sink2);
        float l = 0.f;
#pragma unroll
        for (int kt = 0; kt < 6; ++kt) if (kt >= tile0) {
#pragma unroll
            for (int r = 0; r < 16; ++r) { const float e = __builtin_amdgcn_exp2f(p[kt][r] - mx); p[kt][r] = e; l += e; } }
        l += __shfl_xor(l, 32); l += __builtin_amdgcn_exp2f(sink2 - mx);
        f32x16 o[2]; o[0] = (f32x16){}; o[1] = (f32x16){};
#pragma unroll
        for (int kt = 0; kt < 6; ++kt) if (kt >= tile0) {
#pragma unroll
            for (int j = 0; j < 2; ++j) {
                u32x4 pw; pw.x = cvt_pk_bf16(p[kt][8 * j + 0], p[kt][8 * j + 1]); pw.y = cvt_pk_bf16(p[kt][8 * j + 2], p[kt][8 * j + 3]);
                pw.z = cvt_pk_bf16(p[kt][8 * j + 4], p[kt][8 * j + 5]); pw.w = cvt_pk_bf16(p[kt][8 * j + 6], p[kt][8 * j + 7]);
                const bf16x8 pa = __builtin_bit_cast(bf16x8, pw);
#pragma unroll
                for (int dt = 0; dt < 2; ++dt) { const LAS unsigned char* vp = Vs + (32 * dt + l32) * 392 + (32 * kt + 16 * j + 4 * hi) * 2;
                    const u32x2 lo = *(const LAS u32x2*)vp, hh = *(const LAS u32x2*)(vp + 16);
                    const bf16x8 vb = __builtin_bit_cast(bf16x8, (u32x4){lo.x, lo.y, hh.x, hh.y});
                    o[dt] = __builtin_amdgcn_mfma_f32_32x32x16_bf16(pa, vb, o[dt], 0, 0, 0); } } }
        asm volatile("" ::: "memory"); __builtin_amdgcn_sched_barrier(0);
        if (unit + stride < end) { const AttnGeom Gn = attn_geom(P, unit + stride); attn_load(P, Gn, tid, kr, vr, qn); }
#pragma unroll
        for (int k = 0; k < 4; ++k) { const size_t go = (size_t)(qrow0 + mrow) * DM + 256 * kvh + 64 * k + 8 * mcg;
            mh[k] = *(const u32x4*)(P.H + go); mac[k] = *(const u32x4*)(P.AC + go); mgg[k] = *(const u32x4*)(P.GG + go); mga[k] = *(const u32x4*)(P.GA + go); }
        const float linv = __builtin_amdgcn_rcpf(l);
#pragma unroll
        for (int r = 0; r < 16; ++r) { const int qq = crow(r, hi); const float li = __shfl(linv, qq);
            LAS bf16* op = (LAS bf16*)(OT + (32 * (wid & 1) + qq) * 528) + g * 64 + l32;
            op[0] = f2bf(o[0][r] * li); op[32] = f2bf(o[1][r] * li); }
        __syncthreads();
        { const int row = tid >> 3, cgp = tid & 7; const int grow = qrow0 + row;
#pragma unroll
          for (int k = 0; k < 4; ++k) { const int cl = 64 * k + 8 * cgp, c8 = 256 * kvh + cl; const size_t go = (size_t)grow * DM + c8;
              float ya[8], hh[8], ac[8], gg[8], ga[8], hp[8];
              unpack8(*(const LAS u32x4*)(OT + row * 528 + cl * 2), ya);
              unpack8(mh[k], hh); unpack8(mac[k], ac); unpack8(mgg[k], gg); unpack8(mga[k], ga);
              if (!G.smp) { const f32x4 h0 = *(const f32x4*)(P.HP + (size_t)G.bc * DM + c8), h1 = *(const f32x4*)(P.HP + (size_t)G.bc * DM + c8 + 4);
                  hp[0] = h0.x; hp[1] = h0.y; hp[2] = h0.z; hp[3] = h0.w; hp[4] = h1.x; hp[5] = h1.y; hp[6] = h1.z; hp[7] = h1.w; }
              else {
#pragma unroll
                  for (int e = 0; e < 8; ++e) hp[e] = 0.f; }
              float mx8[8];
#pragma unroll
              for (int e = 0; e < 8; ++e) mx8[e] = gg[e] * (hh[e] + ac[e] * hp[e]) + ga[e] * ya[e];
              *(u32x4*)(P.MIX + go) = pack8(mx8); } }
        __syncthreads();
    }
}

#define XB_TMO      128
#define XB_XCNT(j)  (256  + 64 * (j))
#define XB_XSUB(j)  (1280 + 64 * (j))
#define XB_XGEN(j)  (2304 + 64 * (j))
#define XB_TOP      3328
#define XB_TOPGEN   3392
#define XCD_BAR_WORDS 3456
#define XB_SPIN_CAP (1u << 18)

__device__ __forceinline__ unsigned xb_ld(unsigned* p)              { return __hip_atomic_load(p, __ATOMIC_RELAXED, __HIP_MEMORY_SCOPE_AGENT); }
__device__ __forceinline__ unsigned xb_add(unsigned* p, unsigned v) { return __hip_atomic_fetch_add(p, v, __ATOMIC_RELAXED, __HIP_MEMORY_SCOPE_AGENT); }
__device__ __forceinline__ unsigned xb_xcc_id() { return (unsigned)__builtin_amdgcn_s_getreg((3 << 11) | 20) & 0xFu; }
#define XB_SPIN(cond, bar) do { unsigned _sp = 0; while (cond) { __builtin_amdgcn_s_sleep(1); \
    if ((++_sp & 255u) == 0u) { if (xb_ld(&(bar)[XB_TMO])) break; if (_sp > XB_SPIN_CAP) { atomicAdd(&(bar)[XB_TMO], 1u); break; } } } } while (0)

struct XcdBarrier {
    unsigned* bar; unsigned x;
    volatile LAS unsigned* st;
};

__device__ __forceinline__ XcdBarrier xcd_barrier_post(unsigned* bar, volatile LAS unsigned* st) {
    XcdBarrier b; b.bar = bar; b.x = xb_xcc_id(); b.st = st;
    if (threadIdx.x == 0) (void)xb_add(&bar[XB_XCNT(b.x)], 1u);
    return b;
}
__device__ __forceinline__ void xcd_barrier_complete(unsigned* bar, unsigned x, unsigned& nloc, unsigned& nx) {
    const unsigned G = gridDim.x * gridDim.y * gridDim.z;
    unsigned sum, cnt, mine, sp = 0u;
    for (;;) {
        sum = 0u; cnt = 0u; mine = 0u;
#pragma unroll
        for (unsigned j = 0; j < 16; ++j) { const unsigned c = xb_ld(&bar[XB_XCNT(j)]); sum += c; cnt += (c > 0u) ? 1u : 0u; mine = (j == x) ? c : mine; }
        if (sum == G) break;
        __builtin_amdgcn_s_sleep(1);
        if ((++sp & 255u) == 0u) { if (xb_ld(&bar[XB_TMO])) break; if (sp > XB_SPIN_CAP) { atomicAdd(&bar[XB_TMO], 1u); break; } }
    }
    nloc = mine > 0u ? mine : 1u; nx = cnt > 0u ? cnt : 1u;
}

__device__ __forceinline__ void xcd_barrier(const XcdBarrier& b) {
    asm volatile("s_waitcnt vmcnt(0)" ::: "memory");
    __syncthreads();
    if (threadIdx.x == 0) {
        unsigned* bar = b.bar;
        __builtin_amdgcn_s_waitcnt(0);
        unsigned nloc = b.st[0], nx = b.st[1];
        if (nloc == 0u) { xcd_barrier_complete(bar, b.x, nloc, nx); b.st[0] = nloc; b.st[1] = nx; }
        const unsigned old = xb_add(&bar[XB_XSUB(b.x)], 1u);
        const unsigned gen = old / nloc;
        if (old + 1u == (gen + 1u) * nloc) {
            __builtin_amdgcn_fence(__ATOMIC_RELEASE, "agent");
            asm volatile("s_waitcnt vmcnt(0)" ::: "memory");
            const unsigned og = xb_add(&bar[XB_TOP], 1u);
            const unsigned tg = og / nx;
            if (og + 1u == (tg + 1u) * nx) xb_add(&bar[XB_TOPGEN], 1u);
            else XB_SPIN(xb_ld(&bar[XB_TOPGEN]) == tg, bar);
            __builtin_amdgcn_fence(__ATOMIC_ACQUIRE, "agent");
            xb_add(&bar[XB_XGEN(b.x)], 1u);
            asm volatile("s_waitcnt vmcnt(0)" ::: "memory");
        } else {
            XB_SPIN(xb_ld(&bar[XB_XGEN(b.x)]) == gen, bar);
            __builtin_amdgcn_fence(__ATOMIC_ACQUIRE, "agent");
            asm volatile("s_waitcnt vmcnt(0)" ::: "memory");
        }
    }
    __syncthreads();
}

struct Args { const float* in[24]; float* out; unsigned char* ws; int ph_lo, ph_hi; };
__global__ void __launch_bounds__(512, 2) fwd_kernel(Args args) {
    extern __shared__ __attribute__((aligned(16))) unsigned char lds_raw[];
    LAS unsigned char* lds = (LAS unsigned char*)lds_raw;
    Ctx C;
#pragma unroll
    for (int i = 0; i < 24; ++i) C.in[i] = args.in[i];
    C.out = args.out; C.ws = args.ws; C.tid = threadIdx.x; C.lane = C.tid & 63; C.wave = __builtin_amdgcn_readfirstlane(C.tid >> 6); C.G = gridDim.x; C.bid = blockIdx.x;
    unsigned char* ws = args.ws; float* out = args.out;
    const int lo = args.ph_lo, hi = args.ph_hi;
    volatile LAS unsigned* MISC = (volatile LAS unsigned*)(lds + LDS_MISC);
    if (threadIdx.x < 16) MISC[threadIdx.x] = 0u;
    __syncthreads();
    XcdBarrier bar = xcd_barrier_post((unsigned*)ws, MISC + 8);
#define IN(k) (lo <= (k) && (k) < hi)
#define SEAM(k) do { if (IN(k) && IN((k) + 1)) xcd_barrier(bar); } while (0)
    bf16* B0 = (bf16*)(ws + WS_B0); bf16* XR = (bf16*)(ws + WS_XR); bf16* GG = (bf16*)(ws + WS_GG); bf16* Qb = (bf16*)(ws + WS_Q); bf16* GA = (bf16*)(ws + WS_GA); bf16* AC = (bf16*)(ws + WS_AC);
    bf16* Kp = (bf16*)(ws + WS_K); bf16* KS = (bf16*)(ws + WS_KS); bf16* Vt = (bf16*)(ws + WS_VT); bf16* VTS = (bf16*)(ws + WS_VTS); bf16* HID = (bf16*)(ws + WS_HID);
    float* rstd1 = (float*)(ws + WS_RSTD1); float* ss2 = (float*)(ws + WS_SS2); float* ss3 = (float*)(ws + WS_SS3);
    float* Y2 = (float*)(ws + WS_FU);
    float* CTA = (float*)(ws + WS_CTA); float* CTH = (float*)(ws + WS_CTH); float* HP = (float*)(ws + WS_HP); float* FU = (float*)(ws + WS_FU); float* HU = (float*)(ws + WS_HU);

    if (IN(0)) p0_prologue(C, lds);
    SEAM(0);
    if (IN(1)) {
        { pg8::Gemm g{B0, (const bf16*)(ws + WS_WIN), MT, NMAIN, DM}; pg8::StaticOrder S; S.init(MT, NMAIN, C.G, C.bid);
          EpiMain E{XR, GG, Qb, Kp, KS, GA, rstd1, (const float*)(ws + WS_ROPE), out + O_KP, out + O_KS};
          pg8::gemm_phase<EpiMain, pg8::StaticOrder, true, true>(lds, g, S, E); }
        { pg8::Gemm g{(const bf16*)(ws + WS_WIN) + (size_t)NMAIN * DM, B0, 256, MT, DM}; OffsetOrder S; S.init(256, MT, C.G, C.bid, ((MT / 256) * (NMAIN / 256)) % C.G);
          EpiVt E{Vt, VTS, rstd1, out + O_VP, out + O_VS};
          pg8::gemm_phase<EpiVt, OffsetOrder, true, true>(lds, g, S, E); }
    }
    SEAM(1);
    if (IN(2)) {
        P2Ptrs P{XR, Qb, Kp, KS, Vt, VTS, (const bf16*)(ws + WS_GW), B0, AC, XR, CTA, CTH, GG, GA, HP,
                 C.in[5], C.in[9], C.in[10], C.in[12], C.in[14], C.in[15], C.in[4], C.in[16], out + O_LCP, out + O_LCS, out + O_HS};
        lru_phase(P, lds, C.bid, C.G);
    }
    SEAM(2);
    if (IN(3)) {
        if (C.bid < 32) {
            int t3 = threadIdx.x; asm volatile("" : "+v"(t3));
            const int b = C.bid >> 3, ch = (C.bid & 7) * 128 + (t3 & 127), seg = t3 >> 7; const size_t base = (size_t)(b * 128 + seg * 32) * DM + ch;
            float a[32], h[32];
#pragma unroll
            for (int i = 0; i < 32; ++i) { a[i] = CTA[base + (size_t)i * DM]; h[i] = CTH[base + (size_t)i * DM]; }
            float As = 1.f, hs = 0.f;
#pragma unroll
            for (int i = 0; i < 32; ++i) { hs = a[i] * hs + h[i]; As *= a[i]; }
            LAS f32x2* SG = (LAS f32x2*)lds;
            SG[seg * 128 + (t3 & 127)] = (f32x2){As, hs};
            __syncthreads();
            float carry = 0.f;
#pragma unroll
            for (int s4 = 0; s4 < 3; ++s4) if (s4 < seg) { const f32x2 t = SG[s4 * 128 + (t3 & 127)]; carry = t.x * carry + t.y; }
#pragma unroll
            for (int i = 0; i < 32; ++i) { HP[base + (size_t)i * DM] = carry; carry = a[i] * carry + h[i]; }
            if (seg == 3) out[O_HP + b * DM + ch] = carry;
            __syncthreads();
        } else {
            P2Ptrs P{XR, Qb, Kp, KS, Vt, VTS, (const bf16*)(ws + WS_GW), B0, AC, XR, CTA, CTH, GG, GA, HP,
                     C.in[5], C.in[9], C.in[10], C.in[12], C.in[14], C.in[15], C.in[4], C.in[16], out + O_LCP, out + O_LCS, out + O_HS};
            attn_phase(P, lds, 2048 + C.bid - 32, 2048 + 128, C.G - 32);
        }
    }
    SEAM(3);
    if (IN(4)) {
        if (C.bid < 32) {
            pg8::Gemm g{XR, (const bf16*)(ws + WS_WOUT), MT, DM, DM}; RowOrder S; S.init(MS, DM, C.G, C.bid, MP / 256);
            EpiWout E{C.in[0], C.in[1], B0, ss2};
            pg8::gemm_phase<EpiWout, RowOrder, true, true>(lds, g, S, E);
            __syncthreads();
        }
        {
            P2Ptrs P{XR, Qb, Kp, KS, Vt, VTS, (const bf16*)(ws + WS_GW), B0, AC, XR, CTA, CTH, GG, GA, HP,
                     C.in[5], C.in[9], C.in[10], C.in[12], C.in[14], C.in[15], C.in[4], C.in[16], out + O_LCP, out + O_LCS, out + O_HS};
            constexpr int ATT_TAIL = 5, NSTR = 2048 - 32 * ATT_TAIL;
            if (C.bid < 32) attn_phase(P, lds, NSTR + ATT_TAIL * C.bid, NSTR + ATT_TAIL * (C.bid + 1), 1);
            else attn_phase(P, lds, C.bid - 32, NSTR, C.G - 32);
        }
    }
    SEAM(4);
    if (IN(5)) {
        pg8::Gemm g{XR, (const bf16*)(ws + WS_WOUT), MT, DM, DM}; RowOrder S; S.init(MP, DM, C.G, C.bid, 0);
        EpiWout E{C.in[0], C.in[1], B0, ss2};
        pg8::gemm_phase<EpiWout, RowOrder, true, true>(lds, g, S, E);
    }
    SEAM(5);
    if (IN(6)) {
        pg8::Gemm g{B0, (const bf16*)(ws + WS_WUP), MT, DIN, DM}; pg8::StaticOrder S; S.init(MT, DIN, C.G, C.bid);
        EpiUp E{HID, ss2, C.in[20], C.in[21], C.in[6], FU, HU, out + O_FCP, out + O_FCS, lds + LDS_EX};
        pg8::gemm_phase<EpiUp, pg8::StaticOrder, true, true>(lds, g, S, E);
    }
    SEAM(6);
    if (IN(7)) {
        RowOrder S; S.init(MP, DM, C.G, C.bid, 0);
        { pg8::Unit u; int last = -1; const float* cw = C.in[20]; const float* cb = C.in[21];
          for (int i = 0; S.next(i, u); ++i) { const int pm = u.pm; if (pm == last) continue; last = pm; if (pm >= 128 || (pm & 31) == 0) continue;
              int t7p = threadIdx.x; asm volatile("" : "+v"(t7p));
              for (int ch = t7p; ch < DFF; ch += 512) { const int pnp = ch >> 7, o = ch & 127, gc = pnp * 256 + o, vc = gc + 128;
                  const float* hu = HU + (size_t)((pm - 1) * 2) * DIN; const float* fu = FU + (size_t)(pm * 2) * DIN;
                  const float g2 = hu[gc], g1 = hu[DIN + gc], g0 = fu[gc], gp = fu[DIN + gc], v2 = hu[vc], v1 = hu[DIN + vc], v0 = fu[vc], vp = fu[DIN + vc];
                  const float wg0 = cw[ch], wg1 = cw[DIN + ch], wg2 = cw[2 * DIN + ch], bg = cb[ch], wv0 = cw[DFF + ch], wv1 = cw[DIN + DFF + ch], wv2 = cw[2 * DIN + DFF + ch], bv = cb[DFF + ch];
                  const float ga = bg + wg0 * g2 + wg1 * g1 + wg2 * g0, va = bv + wv0 * v2 + wv1 * v1 + wv2 * v0;
                  const float gb = bg + wg0 * g1 + wg1 * g0 + wg2 * gp, vb = bv + wv0 * v1 + wv1 * v0 + wv2 * vp;
                  HID[(size_t)(pm * 256) * DFF + ch] = f2bf(ga * sigmoidf_(ga) * va); HID[(size_t)(pm * 256 + 1) * DFF + ch] = f2bf(gb * sigmoidf_(gb) * vb); } }
          asm volatile("s_waitcnt vmcnt(0)" ::: "memory"); __syncthreads(); }
        pg8::Gemm g{HID, (const bf16*)(ws + WS_WDN), MT, DM, DFF};
        EpiDown E{B0, out + O_Y, ss3};
        pg8::gemm_phase<EpiDown, RowOrder, true, true>(lds, g, S, E);
    }
    SEAM(7);
#define NORM_ROWS(first_row, n_rows, gwv, ngwv) do { int t7 = threadIdx.x; asm volatile("" : "+v"(t7)); const int lane7 = t7 & 63; const float* gf = C.in[23]; \
        f32x4 gv[4]; _Pragma("unroll") for (int j = 0; j < 4; ++j) gv[j] = ((const f32x4*)gf)[lane7 + 64 * j]; \
        for (int m0 = (first_row) + ((gwv) * 8 + (t7 >> 6)) * 4; m0 < (first_row) + (n_rows); m0 += (ngwv) * 8 * 4) { f32x4 v[4][4]; float rs[4]; \
            _Pragma("unroll") for (int r = 0; r < 4; ++r) { const f32x4* yr = (const f32x4*)(out + O_Y + (size_t)(m0 + r) * DM) + lane7; \
                _Pragma("unroll") for (int j = 0; j < 4; ++j) v[r][j] = yr[64 * j]; } \
            _Pragma("unroll") for (int r = 0; r < 4; ++r) { float sq = 0.f; _Pragma("unroll") for (int j = 0; j < 4; ++j) sq += (v[r][j].x * v[r][j].x + v[r][j].y * v[r][j].y) + (v[r][j].z * v[r][j].z + v[r][j].w * v[r][j].w); \
                rs[r] = __builtin_amdgcn_rsqf(wave_sum(sq) * (1.0f / DM) + RMS_EPS); } \
            _Pragma("unroll") for (int r = 0; r < 4; ++r) { f32x4* yr = (f32x4*)(out + O_Y + (size_t)(m0 + r) * DM) + lane7; \
                _Pragma("unroll") for (int j = 0; j < 4; ++j) yr[64 * j] = v[r][j] * rs[r] * gv[j]; } } } while (0)
    if (IN(8)) {
        if (C.bid < 64) {
            const int kh = C.bid & 1; RowOrder S; S.init(MS, DM, C.G, C.bid >> 1, MP / 256);
            pg8::Gemm g{HID + kh * (DFF / 2), (const bf16*)(ws + WS_WDN) + kh * (DFF / 2), MT, DM, DFF / 2, DFF};
            EpiDown E{kh ? (const bf16*)nullptr : B0, kh ? Y2 - (size_t)MP * DM : out + O_Y, ss3};
            pg8::gemm_phase<EpiDown, RowOrder, true, true>(lds, g, S, E);
        } else { NORM_ROWS(0, MP, C.bid - 64, C.G - 64); }
    }
    SEAM(8);
    if (IN(9)) { int t9 = threadIdx.x; asm volatile("" : "+v"(t9)); const int lane9 = t9 & 63; const float* gf = C.in[23];
        for (int m = MP + C.bid * 8 + (t9 >> 6); m < MT; m += C.G * 8) { f32x4* yr = (f32x4*)(out + O_Y + (size_t)m * DM) + lane9; const f32x4* y2 = (const f32x4*)(Y2 + (size_t)(m - MP) * DM) + lane9;
            f32x4 v[4]; float sq = 0.f;
#pragma unroll
            for (int j = 0; j < 4; ++j) { v[j] = yr[64 * j] + y2[64 * j]; sq += (v[j].x * v[j].x + v[j].y * v[j].y) + (v[j].z * v[j].z + v[j].w * v[j].w); }
            const float rs = __builtin_amdgcn_rsqf(wave_sum(sq) * (1.0f / DM) + RMS_EPS);
#pragma unroll
            for (int j = 0; j < 4; ++j) yr[64 * j] = v[j] * rs * ((const f32x4*)gf)[lane9 + 64 * j]; } }
#undef IN
#undef SEAM
#undef NORM_ROWS
}

extern "C" void kernel_launch(void* const* d_in, const int* in_sizes, int n_in, void* d_out, int out_size, void* d_ws, size_t ws_size, hipStream_t stream) {
    static int grid = 0;
    if (grid == 0) {
        if (n_in != 24 || out_size != (int)O_END || ws_size < WS_END) { fprintf(stderr, "kernel_launch: unexpected shapes: n_in %d out %d ws %zu\n", n_in, out_size, ws_size); grid = -1; return; }
        int dev = 0, cus = 0, per_cu = 0;
        (void)hipGetDevice(&dev); (void)hipDeviceGetAttribute(&cus, hipDeviceAttributeMultiprocessorCount, dev);
        (void)hipFuncSetAttribute((const void*)fwd_kernel, hipFuncAttributeMaxDynamicSharedMemorySize, LDS_BYTES);
        (void)hipOccupancyMaxActiveBlocksPerMultiprocessor(&per_cu, (const void*)fwd_kernel, 512, LDS_BYTES);
        if (per_cu < 1) { fprintf(stderr, "kernel_launch: occupancy query says %d blocks per CU\n", per_cu); grid = -1; return; }
        grid = cus;
    }
    if (grid < 0) return;
    Args a{};
    for (int i = 0; i < 24; ++i) a.in[i] = (const float*)d_in[i];
    a.out = (float*)d_out; a.ws = (unsigned char*)d_ws;
    a.ph_lo = 0; a.ph_hi = 10;
    if (hipMemsetAsync(d_ws, 0, 16384, stream) != hipSuccess) { fprintf(stderr, "kernel_launch: memset of the barrier words failed\n"); return; }
    hipLaunchKernelGGL(fwd_kernel, dim3(grid), dim3(512), LDS_BYTES, stream, a);
}
```

```cpp
#include <hip/hip_runtime.h>
#include <cstdio>
#include <cstdint>
#include <cmath>
namespace pg8 {
#define PG8_LAS __attribute__((address_space(3)))
typedef unsigned short bf16_t;
typedef short bf16x8 __attribute__((ext_vector_type(8)));
typedef float f32x4 __attribute__((ext_vector_type(4)));
typedef unsigned u32x4 __attribute__((ext_vector_type(4)));
constexpr int BM = 256, BK = 64, HALF = 128, HTB = HALF * BK * 2  , STAGE_BYTES = 8 * HTB, NXCD = 8, WGM = 8;

__host__ __device__ __forceinline__ int lds_byte(int r, int c) { const int st = (r >> 4) * 2 + (c >> 5), rr = r & 15, cc = c & 31, ob = rr * 64 + cc * 2; return st * 1024 + (ob ^ (((ob >> 9) & 1) << 5)); }
__host__ __device__ __forceinline__ void stage_rc(int b, int& R, int& C) { const int st = b / 1024, sb = b % 1024, swz = sb ^ (((sb >> 9) & 1) << 5); R = (st >> 1) * 16 + swz / 64; C = (st & 1) * 32 + (swz % 64) / 2; }
__host__ __device__ __forceinline__ int perm32(int rho) { const int n = rho >> 4, i = rho & 15; return 8 * (i >> 2) + 4 * n + (i & 3); }

struct Unit { int pm, pn; };
struct Gemm { const bf16_t* A; const bf16_t* Bt; int M, N, K; int ld = 0; };

struct StaticOrder {
    int nM, nN, nwg, G, c;
    __host__ __device__ __forceinline__ void init(int M, int N, int G_, int c_) { nM = M / BM; nN = N / BM; nwg = nM * nN; G = G_; c = c_; }
    __host__ __device__ __forceinline__ bool next(int i, Unit& u) const {
        const long L = (long)i * G + c; if (L >= nwg) return false;
        int wgid = (int)L; { const int q = nwg / NXCD, r = nwg % NXCD, xcd = wgid % NXCD, off = wgid / NXCD; wgid = (xcd < r ? xcd * (q + 1) : r * (q + 1) + (xcd - r) * q) + off; }
        const int nig = WGM * nN, gid = wgid / nig, fm = gid * WGM, gsz = (nM - fm) < WGM ? (nM - fm) : WGM;
        u.pm = fm + ((wgid % nig) % gsz); u.pn = (wgid % nig) / gsz; return true;
    }
    __device__ __forceinline__ void a_ready(const Unit&) const {}
    __device__ __forceinline__ void done(const Unit&) const {}
};

template <class Epi, class Sched, bool ALIGN_EPI = false, bool SP2 = false>
__device__ __forceinline__ void gemm_phase(PG8_LAS unsigned char* lds, const Gemm g, const Sched& S, const Epi& E) {
    int tid_ = threadIdx.x; asm volatile("" : "+v"(tid_));
    const int tid = tid_, wid = __builtin_amdgcn_readfirstlane(tid >> 6), lane = tid & 63, wr = wid >> 2, wc = wid & 3, fr = lane & 15, fq = lane >> 4;
    const int K = g.ld ? g.ld : g.K, nt = g.K / BK;
    unsigned voffA[2], voffB[2];
#pragma unroll
    for (int i = 0; i < 2; ++i) { int R, C; stage_rc(tid * 16 + i * 8192, R, C); const int Rb = Epi::PERM ? ((R & ~31) + perm32(R & 31)) : R;
        voffA[i] = (unsigned)(R * K + C) * 2u; voffB[i] = (unsigned)(Rb * K + C) * 2u; }
    const size_t kstep = (size_t)(BK * 2);
    const size_t hstep = (size_t)HALF * K * 2;
    const size_t tstep = 2 * hstep;
    const unsigned ldsw = (unsigned)wid * 1024u;
    const int aoff = lds_byte(wr * 64 + fr, fq * 8), boff = lds_byte(wc * 32 + fr, fq * 8);
#define PG8_SA(b, h) (((b) * 2 + (h)) * HTB)
#define PG8_SB(b, h) ((4 + (b) * 2 + (h)) * HTB)
#define PG8_STAGE(bufoff, gbase, voff) do { _Pragma("unroll") for (int _i = 0; _i < 2; ++_i) \
        __builtin_amdgcn_global_load_lds((const unsigned*)((const char*)(gbase) + (voff)[_i]), (PG8_LAS unsigned*)(lds + (bufoff) + ldsw + _i * 8192), 16, 0, 0); } while (0)
#define PG8_LDA(dst, b, h) do { _Pragma("unroll") for (int m = 0; m < 4; ++m) _Pragma("unroll") for (int k = 0; k < 2; ++k) dst[m][k] = *(const PG8_LAS bf16x8*)(lds + PG8_SA(b, h) + aoff + m * 2048 + k * 1024); } while (0)
#define PG8_LDB(dst, b, h) do { _Pragma("unroll") for (int n = 0; n < 2; ++n) _Pragma("unroll") for (int k = 0; k < 2; ++k) dst[n][k] = *(const PG8_LAS bf16x8*)(lds + PG8_SB(b, h) + boff + n * 2048 + k * 1024); } while (0)
#define PG8_MMA(ai, bj, At, Bt) do { __builtin_amdgcn_s_setprio(1); _Pragma("unroll") for (int m = 0; m < 4; ++m) _Pragma("unroll") for (int n = 0; n < 2; ++n) _Pragma("unroll") for (int k = 0; k < 2; ++k) \
        acc[ai][bj][m][n] = __builtin_amdgcn_mfma_f32_16x16x32_bf16(Bt[n][k], At[m][k], acc[ai][bj][m][n], 0, 0, 0); __builtin_amdgcn_s_setprio(0); } while (0)
#define PG8_WAIT_V(n) asm volatile("s_waitcnt vmcnt(" #n ")" ::: "memory")
#define PG8_WAIT_L(n) asm volatile("s_waitcnt lgkmcnt(" #n ")" ::: "memory")
#define PG8_BAR __builtin_amdgcn_s_barrier()
#define PG8_SCHED __builtin_amdgcn_sched_barrier(0)
    Unit cur, nxt; int ui = 0;
    if (!S.next(0, cur)) return;
    f32x4 acc[2][2][4][2];
#pragma unroll
    for (int a = 0; a < 2; ++a)
#pragma unroll
        for (int b = 0; b < 2; ++b)
#pragma unroll
            for (int m = 0; m < 4; ++m)
#pragma unroll
                for (int n = 0; n < 2; ++n) acc[a][b][m][n] = (f32x4){0.f, 0.f, 0.f, 0.f};
    bf16x8 At[4][2], B0[2][2], B1[2][2];
    const char* cA = (const char*)g.A + (size_t)cur.pm * tstep; const char* cB = (const char*)g.Bt + (size_t)cur.pn * tstep;
    S.a_ready(cur);
    if constexpr (SP2) {
        PG8_STAGE(PG8_SB(0, 0), cB, voffB); PG8_STAGE(PG8_SB(0, 1), cB + hstep, voffB); PG8_STAGE(PG8_SA(0, 0), cA, voffA); PG8_STAGE(PG8_SA(0, 1), cA + hstep, voffA);
        if (wr == 1) PG8_BAR;
        PG8_WAIT_V(2); PG8_BAR;
        PG8_STAGE(PG8_SB(1, 0), cB + kstep, voffB); PG8_STAGE(PG8_SA(1, 0), cA + kstep, voffA); PG8_STAGE(PG8_SB(1, 1), cB + hstep + kstep, voffB);
        PG8_WAIT_V(6); PG8_BAR;
    } else {
        PG8_STAGE(PG8_SB(0, 0), cB, voffB); PG8_STAGE(PG8_SA(0, 0), cA, voffA); PG8_STAGE(PG8_SB(0, 1), cB + hstep, voffB); PG8_STAGE(PG8_SA(0, 1), cA + hstep, voffA);
        if (wr == 1) PG8_BAR;
        PG8_WAIT_V(4); PG8_BAR;
        PG8_STAGE(PG8_SB(1, 0), cB + kstep, voffB); PG8_STAGE(PG8_SA(1, 0), cA + kstep, voffA); PG8_STAGE(PG8_SB(1, 1), cB + hstep + kstep, voffB);
        PG8_WAIT_V(6); PG8_BAR;
    }
    for (;;) {
        const bool has_next = S.next(ui + 1, nxt);
        const char* nA = has_next ? (const char*)g.A + (size_t)nxt.pm * tstep : cA; const char* nB = has_next ? (const char*)g.Bt + (size_t)nxt.pn * tstep : cB;
        for (int t = 0; t < nt; t += 2) {
            const bool last = (t == nt - 2);
            const char* a1 = cA + (size_t)(t + 1) * kstep;
            const char* a2 = last ? nA : cA + (size_t)(t + 2) * kstep; const char* b2 = last ? nB : cB + (size_t)(t + 2) * kstep;
            const char* a3 = a2 + kstep; const char* b3 = b2 + kstep;
            if (last && has_next) S.a_ready(nxt);
            if constexpr (SP2) {
            PG8_LDB(B0, 0, 0); PG8_LDB(B1, 0, 1); PG8_SCHED; PG8_LDA(At, 0, 0); PG8_STAGE(PG8_SA(1, 1), a1 + hstep, voffA);
            PG8_WAIT_V(8); PG8_WAIT_L(0); PG8_BAR; PG8_MMA(0, 0, At, B0); PG8_MMA(0, 1, At, B1); PG8_BAR; PG8_SCHED;
            PG8_LDA(At, 0, 1); PG8_STAGE(PG8_SB(0, 0), b2, voffB); PG8_STAGE(PG8_SB(0, 1), b2 + hstep, voffB); PG8_STAGE(PG8_SA(0, 0), a2, voffA);
            PG8_WAIT_V(8); PG8_WAIT_L(0); PG8_BAR; PG8_MMA(1, 0, At, B0); PG8_MMA(1, 1, At, B1); PG8_BAR; PG8_SCHED;
            PG8_LDB(B0, 1, 0); PG8_LDB(B1, 1, 1); PG8_SCHED; PG8_LDA(At, 1, 0); PG8_STAGE(PG8_SA(0, 1), a2 + hstep, voffA);
            PG8_WAIT_V(8); PG8_WAIT_L(0); PG8_BAR; PG8_MMA(0, 0, At, B0); PG8_MMA(0, 1, At, B1); PG8_BAR; PG8_SCHED;
            PG8_LDA(At, 1, 1); PG8_STAGE(PG8_SB(1, 0), b3, voffB); PG8_STAGE(PG8_SB(1, 1), b3 + hstep, voffB); PG8_STAGE(PG8_SA(1, 0), a3, voffA);
            PG8_WAIT_V(8); PG8_WAIT_L(0); PG8_BAR; PG8_MMA(1, 0, At, B0); PG8_MMA(1, 1, At, B1); PG8_BAR; PG8_SCHED;
            } else {
            PG8_LDB(B0, 0, 0); PG8_SCHED; PG8_LDA(At, 0, 0); PG8_STAGE(PG8_SA(1, 1), a1 + hstep, voffA);
            PG8_WAIT_L(8); PG8_BAR; PG8_WAIT_L(0); PG8_MMA(0, 0, At, B0); PG8_BAR; PG8_SCHED;
            PG8_LDB(B1, 0, 1); PG8_STAGE(PG8_SB(0, 0), b2, voffB);
            PG8_BAR; PG8_WAIT_L(0); PG8_MMA(0, 1, At, B1); PG8_BAR;
            PG8_LDA(At, 0, 1); PG8_STAGE(PG8_SA(0, 0), a2, voffA);
            PG8_BAR; PG8_WAIT_L(0); PG8_MMA(1, 0, At, B0); PG8_BAR; PG8_SCHED;
            PG8_STAGE(PG8_SB(0, 1), b2 + hstep, voffB);
            PG8_WAIT_V(6); PG8_BAR; PG8_MMA(1, 1, At, B1); PG8_BAR;
            PG8_LDB(B0, 1, 0); PG8_SCHED; PG8_LDA(At, 1, 0); PG8_STAGE(PG8_SA(0, 1), a2 + hstep, voffA);
            PG8_WAIT_L(8); PG8_BAR; PG8_WAIT_L(0); PG8_MMA(0, 0, At, B0); PG8_BAR; PG8_SCHED;
            PG8_LDB(B1, 1, 1); PG8_STAGE(PG8_SB(1, 0), b3, voffB);
            PG8_BAR; PG8_WAIT_L(0); PG8_MMA(0, 1, At, B1); PG8_BAR;
            PG8_LDA(At, 1, 1); PG8_STAGE(PG8_SA(1, 0), a3, voffA);
            PG8_BAR; PG8_WAIT_L(0); PG8_MMA(1, 0, At, B0); PG8_BAR; PG8_SCHED;
            PG8_STAGE(PG8_SB(1, 1), b3 + hstep, voffB);
            PG8_WAIT_V(6); PG8_BAR; PG8_MMA(1, 1, At, B1); PG8_BAR;
            }
        }
        if constexpr (ALIGN_EPI) { if (wr == 0) PG8_BAR; }
        if constexpr (!Epi::AFTER_DRAIN) { E(acc, cur, wr, wc, fr, fq); S.done(cur); }
        if (!has_next) break;
#pragma unroll
        for (int a = 0; a < 2; ++a)
#pragma unroll
            for (int b = 0; b < 2; ++b)
#pragma unroll
                for (int m = 0; m < 4; ++m)
#pragma unroll
                    for (int n = 0; n < 2; ++n) acc[a][b][m][n] = (f32x4){0.f, 0.f, 0.f, 0.f};
        cur = nxt; cA = nA; cB = nB; ++ui;
        if constexpr (ALIGN_EPI) { if (wr == 1) PG8_BAR; }
    }
    PG8_WAIT_V(0);
    if constexpr (!ALIGN_EPI) { if (wr == 0) PG8_BAR; }
    PG8_BAR;
    if constexpr (Epi::AFTER_DRAIN) { E.fused(acc, cur, wr, wc, fr, fq, lds, wid, lane); S.done(cur); }
#undef PG8_SA
#undef PG8_SB
#undef PG8_STAGE
#undef PG8_LDA
#undef PG8_LDB
#undef PG8_MMA
#undef PG8_WAIT_V
#undef PG8_WAIT_L
#undef PG8_BAR
#undef PG8_SCHED
}
}
typedef float cvt_f32x2_t __attribute__((ext_vector_type(2))); typedef __bf16 cvt_bf16x2_t __attribute__((ext_vector_type(2)));
__device__ __forceinline__ unsigned cvt_pk_bf16(float lo, float hi) { cvt_f32x2_t v = {lo, hi}; cvt_bf16x2_t b = __builtin_convertvector(v, cvt_bf16x2_t); return __builtin_bit_cast(unsigned, b); }

#define LAS __attribute__((address_space(3)))
typedef unsigned short bf16;
typedef float f32x4 __attribute__((ext_vector_type(4)));
typedef float f32x2 __attribute__((ext_vector_type(2)));
typedef float f32x16 __attribute__((ext_vector_type(16)));
typedef unsigned u32x4 __attribute__((ext_vector_type(4)));
typedef unsigned u32x2 __attribute__((ext_vector_type(2)));
typedef short bf16x8 __attribute__((ext_vector_type(8)));

constexpr int MP = 32768, MS = 2048, MT = MP + MS, DM = 1024, DIN = 5632, NMAIN = 5376, DFF = 2816, SEQ = 8192;
constexpr int NCHUNK = MT / 64;
constexpr float RMS_EPS = 1e-6f;
constexpr float LOG2E = 1.4426950408889634f;
constexpr float QSCALE = 0.18033688011112042f;
constexpr size_t MiB = 1u << 20;
constexpr size_t WS_RSTD1 = 64 * 1024, WS_SS2 = 256 * 1024, WS_SS3 = 448 * 1024;
constexpr size_t WS_ROPE = 1 * MiB;
constexpr size_t WS_CTA = 2 * MiB, WS_CTH = 4 * MiB + 256 * 1024, WS_HP = 6 * MiB + 512 * 1024;
constexpr size_t WS_FU = 9 * MiB, WS_HU = 15 * MiB;
constexpr size_t WS_GW = 21 * MiB, WS_WIN = 22 * MiB, WS_WUP = 33 * MiB, WS_WDN = 44 * MiB, WS_WOUT = 50 * MiB;
constexpr size_t WS_KS = 52 * MiB, WS_VTS = 55 * MiB, WS_K = 58 * MiB, WS_VT = 74 * MiB;
constexpr size_t WS_B0 = 90 * MiB, WS_XR = 158 * MiB, WS_GG = 226 * MiB, WS_Q = 294 * MiB, WS_GA = 362 * MiB, WS_AC = 430 * MiB, WS_END = 498 * MiB;
constexpr size_t WS_HID = WS_GG;
constexpr size_t O_Y = 0, O_KP = 35651584, O_VP = 35782656, O_HP = 35913728, O_LCP = 35917824, O_FCP = 35930112,
                 O_KS = 35975168, O_VS = 37023744, O_HS = 38072320, O_LCS = 38105088, O_FCS = 38203392, O_END = 38563840;
constexpr int LDS_BYTES = 163840, LDS_EX = 131072, LDS_MISC = 139264;

__device__ __forceinline__ float bf_lo(unsigned w) { return __builtin_bit_cast(float, w << 16); }
__device__ __forceinline__ float bf_hi(unsigned w) { return __builtin_bit_cast(float, w & 0xffff0000u); }
__device__ __forceinline__ float bf1(bf16 h) { return __builtin_bit_cast(float, (unsigned)h << 16); }
__device__ __forceinline__ bf16 f2bf(float f) { return (bf16)(cvt_pk_bf16(f, 0.f) & 0xffffu); }
__device__ __forceinline__ void unpack8(u32x4 w, float* f) { f[0] = bf_lo(w.x); f[1] = bf_hi(w.x); f[2] = bf_lo(w.y); f[3] = bf_hi(w.y); f[4] = bf_lo(w.z); f[5] = bf_hi(w.z); f[6] = bf_lo(w.w); f[7] = bf_hi(w.w); }
__device__ __forceinline__ u32x4 pack8(const float* f) { u32x4 w; w.x = cvt_pk_bf16(f[0], f[1]); w.y = cvt_pk_bf16(f[2], f[3]); w.z = cvt_pk_bf16(f[4], f[5]); w.w = cvt_pk_bf16(f[6], f[7]); return w; }
__device__ __forceinline__ float sigmoidf_(float x) { return __builtin_amdgcn_rcpf(1.f + __builtin_amdgcn_exp2f(-LOG2E * x)); }
__device__ __forceinline__ void sigmoid2(float x0, float x1, float& s0, float& s1) {
    const float a = 1.f + __builtin_amdgcn_exp2f(fminf(-LOG2E * x0, 60.f)), b = 1.f + __builtin_amdgcn_exp2f(fminf(-LOG2E * x1, 60.f)), r = __builtin_amdgcn_rcpf(a * b);
    s0 = b * r; s1 = a * r;
}
template <int N> __device__ __forceinline__ float dpp_ror(float v) { return __builtin_bit_cast(float, __builtin_amdgcn_update_dpp(0, __builtin_bit_cast(int, v), 0x120 + N, 0xf, 0xf, false)); }
__device__ __forceinline__ float gelu_tanh(float x) { const float z = 1.5957691216057308f * (x + 0.044715f * x * x * x); return x * sigmoidf_(z); }
__device__ __forceinline__ int crow(int r, int hi) { return (r & 3) + 8 * (r >> 2) + 4 * hi; }
__device__ __forceinline__ float wave_sum(float v) {
#pragma unroll
    for (int o = 1; o < 64; o <<= 1) v += __shfl_xor(v, o);
    return v;
}

struct Ctx {
    const float* in[24]; float* out; unsigned char* ws;
    int tid, lane, wave, G, bid;
};
__device__ __forceinline__ const float* xrow(const Ctx& C, int r) { return r < MP ? C.in[0] + (size_t)r * DM : C.in[1] + (size_t)(r - MP) * DM; }
__device__ __forceinline__ int pos_of_row(int r) { return r < MP ? (r & (SEQ - 1)) : 1024 + ((r - MP) & 63); }

__device__ __forceinline__ void tr_item(const float* W, int ldn, int ncol0, int k0, bf16* WT, int Kd, int drow0, const float* g, LAS float* scr, int lane) {
    float wv[32];
#pragma unroll
    for (int i = 0; i < 32; ++i) wv[i] = W[(size_t)(k0 + 2 * i + (lane >> 5)) * ldn + ncol0 + (lane & 31)];
#pragma unroll
    for (int i = 0; i < 32; ++i) { const int kk = 2 * i + (lane >> 5); float v = wv[i]; if (g) v *= g[k0 + kk]; scr[kk * 33 + (lane & 31)] = v; }
    asm volatile("s_waitcnt lgkmcnt(0)" ::: "memory");
    const int c = lane & 7;
#pragma unroll
    for (int j = 0; j < 4; ++j) { const int n = (lane >> 3) + 8 * j; const LAS float* s = scr + (8 * c) * 33 + n;
        u32x4 o; o.x = cvt_pk_bf16(s[0 * 33], s[1 * 33]); o.y = cvt_pk_bf16(s[2 * 33], s[3 * 33]); o.z = cvt_pk_bf16(s[4 * 33], s[5 * 33]); o.w = cvt_pk_bf16(s[6 * 33], s[7 * 33]);
        *(u32x4*)(WT + (size_t)(drow0 + n) * Kd + k0 + 8 * c) = o; }
    asm volatile("s_waitcnt lgkmcnt(0)" ::: "memory");
}
__device__ __forceinline__ int win_src_col(int d) {
    if (d < 1024) return d;
    if (d < 3072) { const int j = (d - 1024) >> 8, o = (d - 1024) & 255; return o < 128 ? 1024 + 128 * j + o : 3584 + 128 * j + (o - 128); }
    if (d < 4096) return 2048 + (d - 3072);
    if (d < 4352) return 3072 + (d - 4096);
    if (d < 5376) return 4608 + (d - 4352);
    return 3328 + (d - 5376);
}
__device__ __forceinline__ void sincos_d(double a, float& s, float& c) {
    const double k = rint(a * 0.6366197723675814);
    double r = fma(-k, 1.5707963267948966, a); r = fma(-k, 6.123233995736766e-17, r);
    const int q = ((int)k) & 3; const double r2 = r * r;
    const double sp = r * (1.0 + r2 * (-1.0 / 6 + r2 * (1.0 / 120 + r2 * (-1.0 / 5040 + r2 * (1.0 / 362880 + r2 * (-1.0 / 39916800))))));
    const double cp = 1.0 + r2 * (-0.5 + r2 * (1.0 / 24 + r2 * (-1.0 / 720 + r2 * (1.0 / 40320 + r2 * (-1.0 / 3628800 + r2 * (1.0 / 479001600))))));
    const double ss = (q == 0) ? sp : (q == 1) ? cp : (q == 2) ? -sp : -cp;
    const double cc = (q == 0) ? cp : (q == 1) ? -sp : (q == 2) ? -cp : sp;
    s = (float)ss; c = (float)cc;
}
__device__ __forceinline__ void p0_prologue(const Ctx& C, LAS unsigned char* lds) {
    unsigned char* ws = C.ws;
    LAS float* scr = (LAS float*)(lds + C.wave * 16384);
    const int gw = C.bid * 8 + C.wave, NGW = C.G * 8, gt = C.bid * 512 + C.tid, GT = C.G * 512;
    constexpr int I_IN = (DIN / 32) * 16, I_UP = (DIN / 32) * 16, I_OUT = 32 * 16, I_DN = 32 * 44;
    for (int it = gw; it < I_IN + I_UP + I_OUT + I_DN; it += NGW) {
        int r = it;
        if (r < I_IN) { const int rg = r >> 4, kb = r & 15; tr_item(C.in[8], DIN, win_src_col(32 * rg), 64 * kb, (bf16*)(ws + WS_WIN), DM, 32 * rg, C.in[7], scr, C.lane); continue; } r -= I_IN;
        if (r < I_UP) { const int rg = r >> 4, kb = r & 15, d = 32 * rg, pn = d >> 8, o = d & 255; const int src = o < 128 ? 128 * pn + o : DFF + 128 * pn + (o - 128);
                        tr_item(C.in[19], DIN, src, 64 * kb, (bf16*)(ws + WS_WUP), DM, d, C.in[18], scr, C.lane); continue; } r -= I_UP;
        if (r < I_OUT) { const int rg = r >> 4, kb = r & 15; tr_item(C.in[17], DM, 32 * rg, 64 * kb, (bf16*)(ws + WS_WOUT), DM, 32 * rg, nullptr, scr, C.lane); continue; } r -= I_OUT;
        { const int rg = r / 44, kb = r % 44; tr_item(C.in[22], DM, 32 * rg, 64 * kb, (bf16*)(ws + WS_WDN), DFF, 32 * rg, nullptr, scr, C.lane); }
    }
    { bf16* GW = (bf16*)(ws + WS_GW);
      for (int e = gt; e < 2 * 16 * 64 * 64; e += GT) { const int c = e & 63, d = (e >> 6) & 63, nb = (e >> 12) & 15, g = e >> 16;
          const float* W = g ? C.in[13] : C.in[11]; GW[e] = f2bf(W[(nb * 64 + c) * 64 + d]); } }
    { float* rope = (float*)(ws + WS_ROPE);
      const double INVF[8] = {1.0, 0.1939227447486858, 0.03760603093086394, 0.007292664737217109, 0.0014142135623730955, 0.00027424817567620724, 5.318295896944988e-05, 1.0313385377212461e-05};
      for (int e = gt; e < SEQ * 8; e += GT) { const int pos = e >> 3, j = e & 7;
          const double f = (j == 0) ? INVF[0] : (j == 1) ? INVF[1] : (j == 2) ? INVF[2] : (j == 3) ? INVF[3] : (j == 4) ? INVF[4] : (j == 5) ? INVF[5] : (j == 6) ? INVF[6] : INVF[7];
          float s, c; sincos_d((double)pos * f, s, c); rope[pos * 16 + j] = c; rope[pos * 16 + 8 + j] = s; } }
    { bf16* XB = (bf16*)(ws + WS_B0); float* rstd1 = (float*)(ws + WS_RSTD1);
      for (int m0 = gw * 4; m0 < MT; m0 += NGW * 4) {
          f32x4 v[4][4];
#pragma unroll
          for (int r = 0; r < 4; ++r) { const f32x4* xr = (const f32x4*)xrow(C, m0 + r) + C.lane;
#pragma unroll
              for (int j = 0; j < 4; ++j) v[r][j] = xr[64 * j]; }
#pragma unroll
          for (int r = 0; r < 4; ++r) { float s = 0.f;
#pragma unroll
              for (int j = 0; j < 4; ++j) s += (v[r][j].x * v[r][j].x + v[r][j].y * v[r][j].y) + (v[r][j].z * v[r][j].z + v[r][j].w * v[r][j].w);
              s = wave_sum(s);
              if (C.lane == 0) rstd1[m0 + r] = 1.0f / sqrtf(s * (1.0f / DM) + RMS_EPS);
              u32x2* o8 = (u32x2*)(XB + (size_t)(m0 + r) * DM) + C.lane;
#pragma unroll
              for (int j = 0; j < 4; ++j) { u32x2 w; w.x = cvt_pk_bf16(v[r][j].x, v[r][j].y); w.y = cvt_pk_bf16(v[r][j].z, v[r][j].w); o8[64 * j] = w; } } } }
    { bf16* KS = (bf16*)(ws + WS_KS); bf16* VTS = (bf16*)(ws + WS_VTS); const float* ck = C.in[2]; const float* cv = C.in[3];
      for (int e = gt; e < 32 * 128 * 32; e += GT) { const int c8 = (e & 31) * 8, r = (e >> 5) & 127, b = e >> 12;
          const f32x4* s = (const f32x4*)(ck + ((size_t)(b * 128 + r) * 256 + c8)); const f32x4 a0 = s[0], a1 = s[1];
          u32x4 w; w.x = cvt_pk_bf16(a0.x, a0.y); w.y = cvt_pk_bf16(a0.z, a0.w); w.z = cvt_pk_bf16(a1.x, a1.y); w.w = cvt_pk_bf16(a1.z, a1.w);
          *(u32x4*)(KS + ((size_t)(b * 192 + r) * 256 + c8)) = w; }
      for (int e = gt; e < 32 * 16 * 256; e += GT) { const int col = e & 255, r8 = (e >> 8) & 15, b = e >> 12; float f[8];
#pragma unroll
          for (int i = 0; i < 8; ++i) f[i] = cv[(size_t)(b * 128 + r8 * 8 + i) * 256 + col];
          *(u32x4*)(VTS + ((size_t)(b * 256 + col) * 192 + r8 * 8)) = pack8(f); }
      float* oks = C.out + O_KS; float* ovs = C.out + O_VS;
      for (int e = gt; e < 32 * 64 * 64; e += GT) { const int c4 = (e & 63) * 4, r = (e >> 6) & 63, b = e >> 12;
          *(f32x4*)(oks + ((size_t)(b * 128 + r) * 256 + c4)) = *(const f32x4*)(ck + ((size_t)(b * 128 + 64 + r) * 256 + c4));
          *(f32x4*)(ovs + ((size_t)(b * 128 + r) * 256 + c4)) = *(const f32x4*)(cv + ((size_t)(b * 128 + 64 + r) * 256 + c4)); } }
    { float* ss2 = (float*)(ws + WS_SS2); float* ss3 = (float*)(ws + WS_SS3);
      for (int e = gt; e < MT; e += GT) { ss2[e] = 0.f; ss3[e] = 0.f; } }
}

struct EpiMain {
    static constexpr bool PERM = true, AFTER_DRAIN = false;
    bf16 *XR, *GG, *Q, *Kp, *KS, *GA; const float* rstd1; const float* rope; float *okp, *oks;
#define EM_ROWS_BEGIN _Pragma("unroll") for (int ai = 0; ai < 2; ++ai) _Pragma("unroll") for (int m = 0; m < 4; ++m) { \
        const int row = u.pm * 256 + ai * 128 + wr * 64 + m * 16 + fr; const float rs = rsv[ai * 4 + m]; float v[2][8]; \
        _Pragma("unroll") for (int bj = 0; bj < 2; ++bj) _Pragma("unroll") for (int n = 0; n < 2; ++n) _Pragma("unroll") for (int e = 0; e < 4; ++e) v[bj][4 * n + e] = acc[ai][bj][m][n][e] * rs;
#define EM_ROWS_END }
    __device__ __forceinline__ void operator()(pg8::f32x4 (&acc)[2][2][4][2], const pg8::Unit& u, int wr, int wc, int fr, int fq) const {
        const int pn = u.pn; int cw = wc * 32 + 8 * fq;
        float rsv[8];
#pragma unroll
        for (int i = 0; i < 8; ++i) rsv[i] = rstd1[u.pm * 256 + (i >> 2) * 128 + wr * 64 + (i & 3) * 16 + fr];
        asm volatile("" : "+v"(cw));
        if (pn < 4) {
            EM_ROWS_BEGIN
#pragma unroll
                for (int bj = 0; bj < 2; ++bj) *(u32x4*)(XR + (size_t)row * DM + pn * 256 + bj * 128 + cw) = pack8(v[bj]);
            EM_ROWS_END
        } else if (pn < 12) {
            EM_ROWS_BEGIN
                float g[8];
#pragma unroll
                for (int i = 0; i < 8; ++i) { const float y = v[0][i], z = 1.5957691216057308f * (y + 0.044715f * y * y * y);
                    const float e1 = 1.f + __builtin_amdgcn_exp2f(fminf(-LOG2E * z, 60.f)), e2 = 1.f + __builtin_amdgcn_exp2f(fminf(-LOG2E * v[1][i], 60.f));
                    g[i] = y * __builtin_amdgcn_rcpf(e1 * e2); }
                *(u32x4*)(GG + (size_t)row * DM + (pn - 4) * 128 + cw) = pack8(g);
            EM_ROWS_END
        } else if (pn < 17) {
            const bool rot = (wc & 1) == 0;
            EM_ROWS_BEGIN
                const int pos = pos_of_row(row);
                const f32x4* rp = (const f32x4*)(rope + pos * 16);
                const f32x4 c0 = rp[0], c1 = rp[1], s0 = rp[2], s1 = rp[3];
                const float cs[8] = {c0.x, c0.y, c0.z, c0.w, c1.x, c1.y, c1.z, c1.w}, sn[8] = {s0.x, s0.y, s0.z, s0.w, s1.x, s1.y, s1.z, s1.w};
#pragma unroll
                for (int bj = 0; bj < 2; ++bj)
#pragma unroll
                    for (int i = 0; i < 8; ++i) {
                        const float mine = v[bj][i], other = __shfl_xor(mine, 16);
                        const float r0 = mine * cs[i] - other * sn[i], r1 = mine * cs[i] + other * sn[i];
                        v[bj][i] = (rot && fq == 0) ? r0 : (rot && fq == 1) ? r1 : mine;
                    }
                if (pn < 16) {
#pragma unroll
                    for (int bj = 0; bj < 2; ++bj) { float q[8];
#pragma unroll
                        for (int i = 0; i < 8; ++i) q[i] = v[bj][i] * QSCALE;
                        *(u32x4*)(Q + (size_t)row * DM + (pn - 12) * 256 + bj * 128 + cw) = pack8(q); }
                } else if (u.pm < 128) {
#pragma unroll
                    for (int bj = 0; bj < 2; ++bj) *(u32x4*)(Kp + (size_t)row * 256 + bj * 128 + cw) = pack8(v[bj]);
                    if ((u.pm & 31) == 31 && ai == 1) { const int b = u.pm >> 5, tt = wr * 64 + m * 16 + fr;
#pragma unroll
                        for (int bj = 0; bj < 2; ++bj) { float* o = okp + ((size_t)(b * 128 + tt) * 256 + bj * 128 + cw);
                            *(f32x4*)o = (f32x4){v[bj][0], v[bj][1], v[bj][2], v[bj][3]}; *(f32x4*)(o + 4) = (f32x4){v[bj][4], v[bj][5], v[bj][6], v[bj][7]}; } }
                } else {
                    const int rr = row - MP, sb = rr >> 6, t = rr & 63;
#pragma unroll
                    for (int bj = 0; bj < 2; ++bj) { *(u32x4*)(KS + ((size_t)(sb * 192 + 128 + t) * 256 + bj * 128 + cw)) = pack8(v[bj]);
                        float* o = oks + ((size_t)(sb * 128 + 64 + t) * 256 + bj * 128 + cw);
                        *(f32x4*)o = (f32x4){v[bj][0], v[bj][1], v[bj][2], v[bj][3]}; *(f32x4*)(o + 4) = (f32x4){v[bj][4], v[bj][5], v[bj][6], v[bj][7]}; }
                }
            EM_ROWS_END
        } else {
            EM_ROWS_BEGIN
#pragma unroll
                for (int bj = 0; bj < 2; ++bj) { float g[8];
#pragma unroll
                    for (int i = 0; i < 8; i += 2) sigmoid2(v[bj][i], v[bj][i + 1], g[i], g[i + 1]);
                    *(u32x4*)(GA + (size_t)row * DM + (pn - 17) * 256 + bj * 128 + cw) = pack8(g); }
            EM_ROWS_END
        }
    }
#undef EM_ROWS_BEGIN
#undef EM_ROWS_END
};
struct EpiVt {
    static constexpr bool PERM = true, AFTER_DRAIN = false;
    bf16 *Vt, *VTS; const float* rstd1; float *ovp, *ovs;
    __device__ __forceinline__ void operator()(pg8::f32x4 (&acc)[2][2][4][2], const pg8::Unit& u, int wr, int wc, int fr, int fq) const {
        const bool smp = u.pn >= 128, keep = (u.pn & 31) == 31;
#pragma unroll
        for (int bj = 0; bj < 2; ++bj) {
            const int tok0 = u.pn * 256 + bj * 128 + wc * 32 + 8 * fq;
            const f32x4 r0 = *(const f32x4*)(rstd1 + tok0), r1 = *(const f32x4*)(rstd1 + tok0 + 4);
            const float rs[8] = {r0.x, r0.y, r0.z, r0.w, r1.x, r1.y, r1.z, r1.w};
            const int rr = tok0 - MP, sb = rr >> 6, t = rr & 63;
            bf16* dst = smp ? VTS + ((size_t)(sb * 256) * 192 + 128 + t) : Vt + tok0; const size_t dstride = smp ? 192 : MP;
            float* kp = smp ? ovs + (size_t)(sb * 128 + 64 + t) * 256 : ovp + (size_t)((u.pn >> 5) * 128 + wc * 32 + 8 * fq) * 256;
            const bool kflag = smp || (keep && bj == 1);
#pragma unroll
            for (int ai = 0; ai < 2; ++ai)
#pragma unroll
                for (int m = 0; m < 4; ++m) {
                    const int vcol = ai * 128 + wr * 64 + m * 16 + fr; float v[8];
#pragma unroll
                    for (int n = 0; n < 2; ++n)
#pragma unroll
                        for (int e = 0; e < 4; ++e) v[4 * n + e] = acc[ai][bj][m][n][e] * rs[4 * n + e];
                    *(u32x4*)(dst + (size_t)vcol * dstride) = pack8(v);
                    if (kflag) {
#pragma unroll
                        for (int i = 0; i < 8; ++i) kp[i * 256 + vcol] = v[i]; }
                    asm volatile("" ::: "memory");
                }
        }
    }
};
struct EpiWout {
    static constexpr bool PERM = false, AFTER_DRAIN = false;
    const float *xp, *xs; bf16* X1B; float* ss2;
    __device__ __forceinline__ void operator()(pg8::f32x4 (&acc)[2][2][4][2], const pg8::Unit& u, int wr, int wc, int fr, int fq) const {
        int cb = u.pn * 256 + wc * 32 + 4 * fq; asm volatile("" : "+v"(cb));
#pragma unroll
        for (int ai = 0; ai < 2; ++ai) {
            f32x4 xv[4][2][2];
#pragma unroll
            for (int m = 0; m < 4; ++m) { const int row = u.pm * 256 + ai * 128 + wr * 64 + m * 16 + fr;
                const float* xr = row < MP ? xp + (size_t)row * DM : xs + (size_t)(row - MP) * DM;
#pragma unroll
                for (int bj = 0; bj < 2; ++bj)
#pragma unroll
                    for (int n = 0; n < 2; ++n) xv[m][bj][n] = *(const f32x4*)(xr + cb + bj * 128 + 16 * n); }
#pragma unroll
            for (int m = 0; m < 4; ++m) { const int row = u.pm * 256 + ai * 128 + wr * 64 + m * 16 + fr; float s = 0.f;
#pragma unroll
                for (int bj = 0; bj < 2; ++bj)
#pragma unroll
                    for (int n = 0; n < 2; ++n) { const f32x4 y = xv[m][bj][n] + acc[ai][bj][m][n];
                        s += (y.x * y.x + y.y * y.y) + (y.z * y.z + y.w * y.w);
                        u32x2 w; w.x = cvt_pk_bf16(y.x, y.y); w.y = cvt_pk_bf16(y.z, y.w); *(u32x2*)(X1B + (size_t)row * DM + cb + bj * 128 + 16 * n) = w; }
                s += __shfl_xor(s, 16); s += __shfl_xor(s, 32);
                if (fq == 0) unsafeAtomicAdd(ss2 + row, s); }
            asm volatile("" ::: "memory");
        }
    }
};
struct EpiDown {
    static constexpr bool PERM = false, AFTER_DRAIN = false;
    const bf16* X1B; float* Y; float* ss3;
    __device__ __forceinline__ void operator()(pg8::f32x4 (&acc)[2][2][4][2], const pg8::Unit& u, int wr, int wc, int fr, int fq) const {
        int cb = u.pn * 256 + wc * 32 + 4 * fq; asm volatile("" : "+v"(cb));
        u32x2 xb[2][4][2][2];
#pragma unroll
        for (int ai = 0; ai < 2; ++ai)
#pragma unroll
            for (int m = 0; m < 4; ++m) { const size_t ro = (size_t)(u.pm * 256 + ai * 128 + wr * 64 + m * 16 + fr) * DM;
#pragma unroll
                for (int bj = 0; bj < 2; ++bj)
#pragma unroll
                    for (int n = 0; n < 2; ++n) xb[ai][m][bj][n] = X1B ? *(const u32x2*)(X1B + ro + cb + bj * 128 + 16 * n) : (u32x2){0u, 0u}; }
#pragma unroll
        for (int ai = 0; ai < 2; ++ai)
#pragma unroll
            for (int m = 0; m < 4; ++m) { const size_t ro = (size_t)(u.pm * 256 + ai * 128 + wr * 64 + m * 16 + fr) * DM;
#pragma unroll
                for (int bj = 0; bj < 2; ++bj)
#pragma unroll
                    for (int n = 0; n < 2; ++n) { const u32x2 x = xb[ai][m][bj][n];
                        *(f32x4*)(Y + ro + cb + bj * 128 + 16 * n) = (f32x4){bf_lo(x.x), bf_hi(x.x), bf_lo(x.y), bf_hi(x.y)} + acc[ai][bj][m][n]; } }
    }
};
struct EpiUp {
    static constexpr bool PERM = true, AFTER_DRAIN = false;
    bf16* HID; const float* ss2; const float* cw; const float* cb; const float* fstate; float *FU, *HU, *ofcp, *ofcs; LAS unsigned char* ex;
    __device__ __forceinline__ void operator()(pg8::f32x4 (&acc)[2][2][4][2], const pg8::Unit& u, int wr, int wc, int fr, int fq) const {
        const int pm = u.pm, pn = u.pn, lane = threadIdx.x & 63; const bool smp = pm >= 128;
        const int cw8 = wc * 32 + 8 * fq;
#pragma unroll
        for (int ai = 0; ai < 2; ++ai)
#pragma unroll
            for (int m = 0; m < 4; ++m) { const int row = pm * 256 + ai * 128 + wr * 64 + m * 16 + fr; const float rs = __builtin_amdgcn_rsqf(ss2[row] * (1.0f / DM) + RMS_EPS);
#pragma unroll
                for (int bj = 0; bj < 2; ++bj)
#pragma unroll
                    for (int n = 0; n < 2; ++n) acc[ai][bj][m][n] = acc[ai][bj][m][n] * rs; }
        LAS float* EX = (LAS float*)ex;
        if (fr >= 14) {
#pragma unroll
            for (int ai = 0; ai < 2; ++ai)
#pragma unroll
                for (int bj = 0; bj < 2; ++bj)
#pragma unroll
                    for (int n = 0; n < 2; ++n) {
                        const f32x4 v = acc[ai][bj][3][n]; const int srccol = bj * DFF + pn * 128 + cw8 + 4 * n, cl = bj * 128 + cw8 + 4 * n;
                        *(LAS f32x4*)(EX + ((ai * 2 + wr) * 2 + (fr - 14)) * 256 + cl) = v;
                        if (smp) { const int st = 4 * (pm - 128) + 2 * ai + wr; *(f32x4*)(ofcs + (size_t)(st * 2 + fr - 14) * DIN + srccol) = v; }
                        else if (ai == 1 && wr == 1) { *(f32x4*)(HU + (size_t)(pm * 2 + fr - 14) * DIN + pn * 256 + cl) = v;
                            if ((pm & 31) == 31) *(f32x4*)(ofcp + (size_t)((pm >> 5) * 2 + fr - 14) * DIN + srccol) = v; }
                    }
        }
        if (!smp && fr < 2 && wr == 0) {
#pragma unroll
            for (int bj = 0; bj < 2; ++bj)
#pragma unroll
                for (int n = 0; n < 2; ++n) *(f32x4*)(FU + (size_t)(pm * 2 + fr) * DIN + pn * 256 + bj * 128 + cw8 + 4 * n) = acc[0][bj][0][n];
        }
        asm volatile("s_waitcnt lgkmcnt(0)" ::: "memory"); __builtin_amdgcn_s_barrier(); asm volatile("" ::: "memory");
#pragma unroll
        for (int bj = 0; bj < 2; ++bj)
#pragma unroll
            for (int n = 0; n < 2; ++n) {
                const int srccol = bj * DFF + pn * 128 + cw8 + 4 * n, cl = bj * 128 + cw8 + 4 * n;
                const f32x4 w0 = *(const f32x4*)(cw + srccol), w1 = *(const f32x4*)(cw + DIN + srccol), w2 = *(const f32x4*)(cw + 2 * DIN + srccol), bb = *(const f32x4*)(cb + srccol);
#pragma unroll
                for (int ai = 0; ai < 2; ++ai) {
                    const int st = smp ? 4 * (pm - 128) + 2 * ai + wr : 0, hr = fr >= 14 ? fr - 14 : 0;
                    const f32x4 hvF = *(const f32x4*)(fstate + (size_t)(st * 2 + hr) * DIN + srccol);
                    const int exb = (wr == 1) ? ai * 2 : 1;
                    const f32x4 hvE = *(const LAS f32x4*)(EX + (exb * 2 + hr) * 256 + cl);
                    const bool useE = !smp && (wr == 1 || ai == 1);
                    f32x4 hv;
#pragma unroll
                    for (int e = 0; e < 4; ++e) hv[e] = smp ? hvF[e] : (useE ? hvE[e] : 0.f);
#pragma unroll
                    for (int e = 0; e < 4; ++e) {
                        float c1 = dpp_ror<1>(acc[ai][bj][3][n][e]), c2 = dpp_ror<2>(acc[ai][bj][3][n][e]);
#pragma unroll
                        for (int m = 3; m >= 0; --m) {
                            const float pv = (m > 0) ? acc[ai][bj][m > 0 ? m - 1 : 0][n][e] : hv[e];
                            const float q1 = dpp_ror<1>(pv), q2 = dpp_ror<2>(pv);
                            const float p1 = fr >= 1 ? c1 : q1, p2 = fr >= 2 ? c2 : q2;
                            float res = bb[e] + w0[e] * p2 + w1[e] * p1 + w2[e] * acc[ai][bj][m][n][e];
                            asm volatile("" : "+v"(res));
                            acc[ai][bj][m][n][e] = res;
                            c1 = q1; c2 = q2;
                        }
                        __builtin_amdgcn_sched_barrier(0);
                    }
                    asm volatile("" ::: "memory");
                }
            }
#pragma unroll
        for (int ai = 0; ai < 2; ++ai)
#pragma unroll
            for (int m = 0; m < 4; ++m) { const int row = pm * 256 + ai * 128 + wr * 64 + m * 16 + fr; float h[8];
#pragma unroll
                for (int n = 0; n < 2; ++n)
#pragma unroll
                    for (int e = 0; e < 4; e += 2) { const float g0 = acc[ai][0][m][n][e], g1 = acc[ai][0][m][n][e + 1]; float s0, s1; sigmoid2(g0, g1, s0, s1);
                        h[4 * n + e] = g0 * s0 * acc[ai][1][m][n][e]; h[4 * n + e + 1] = g1 * s1 * acc[ai][1][m][n][e + 1]; }
                *(u32x4*)(HID + (size_t)row * DFF + pn * 128 + cw8) = pack8(h); }
    }
};
struct OffsetOrder {
    pg8::StaticOrder S;
    __device__ __forceinline__ void init(int M, int N, int G, int c, int off) { S.init(M, N, G, (c - off + G) % G); }
    __device__ __forceinline__ bool next(int i, pg8::Unit& u) const { return S.next(i, u); }
    __device__ __forceinline__ void a_ready(const pg8::Unit&) const {}
    __device__ __forceinline__ void done(const pg8::Unit&) const {}
};

struct RowOrder {
    pg8::StaticOrder S; int pm0;
    __device__ __forceinline__ void init(int Mrows, int N, int G, int c, int pm0_) { S.init(Mrows, N, G, c); pm0 = pm0_; }
    __device__ __forceinline__ bool next(int i, pg8::Unit& u) const { if (!S.next(i, u)) return false; u.pm += pm0; return true; }
    __device__ __forceinline__ void a_ready(const pg8::Unit&) const {}
    __device__ __forceinline__ void done(const pg8::Unit&) const {}
};

struct P2Ptrs {
    const bf16 *XR, *Q, *Kp, *KS, *Vt, *VTS, *GW; bf16 *H, *AC, *MIX; float *CTA, *CTH; const bf16 *GG, *GA; const float* HP;
    const float *lconv, *cw, *cb, *gab, *gib, *lam, *h0, *sinks; float *olcp, *olcs, *ohs;
};
__device__ __forceinline__ void lru_load_x(const P2Ptrs& P, int unit, int tid, u32x4 (&raw)[5]) {
    const int cgp = unit & 7, cidx = unit >> 3; const bool smp = cidx >= 512; const int row0 = cidx * 64, cib = cidx & 127, co = tid & 15, rg = tid >> 4, chb = 128 * cgp + 8 * co;
#pragma unroll
    for (int k = 0; k < 5; ++k) { const int tr = 2 * rg - 3 + k;
        if (tr >= 0 || (!smp && cib > 0)) raw[k] = *(const u32x4*)(P.XR + (size_t)(row0 + tr) * DM + chb); else raw[k] = (u32x4){0u, 0u, 0u, 0u}; }
}
__device__ __forceinline__ void lru_phase(const P2Ptrs& P, LAS unsigned char* lds, int bid, int G) {
    int tid_ = threadIdx.x; asm volatile("" : "+v"(tid_));
    const int tid = tid_, lane = tid & 63, wid = tid >> 6, l32 = lane & 31, hi = lane >> 5;
    LAS unsigned char* XC = lds;
    LAS f32x2* AU = (LAS f32x2*)(lds + 17408);
    LAS f32x2* SEG = (LAS f32x2*)(lds + 17408 + 65536);
    const int co = tid & 15, rg = tid >> 4, nbl = wid >> 2, rh = (wid >> 1) & 1, chh = wid & 1;
    int cur = -1; float cwt[4][8], cbs[8]; bf16x8 wa[4], wi[4]; float bga = 0.f, bgi = 0.f, c8 = 0.f;
    u32x4 raw[5];
    const int NU = NCHUNK * 8;
    if (bid < NU) lru_load_x(P, bid, tid, raw);
    for (int unit = bid; unit < NU; unit += G) {
        const int cgp = unit & 7, cidx = unit >> 3; const bool smp = cidx >= 512; const int row0 = cidx * 64, cib = cidx & 127, sb = cidx - 512, ch0 = 128 * cgp;
        const int chb = ch0 + 8 * co, chl = 64 * nbl + 32 * chh + l32;
        if (cgp != cur) { cur = cgp;
#pragma unroll
            for (int j = 0; j < 4; ++j) { const f32x4 a0 = *(const f32x4*)(P.cw + j * DM + chb), a1 = *(const f32x4*)(P.cw + j * DM + chb + 4);
                cwt[j][0] = a0.x; cwt[j][1] = a0.y; cwt[j][2] = a0.z; cwt[j][3] = a0.w; cwt[j][4] = a1.x; cwt[j][5] = a1.y; cwt[j][6] = a1.z; cwt[j][7] = a1.w; }
            { const f32x4 a0 = *(const f32x4*)(P.cb + chb), a1 = *(const f32x4*)(P.cb + chb + 4);
              cbs[0] = a0.x; cbs[1] = a0.y; cbs[2] = a0.z; cbs[3] = a0.w; cbs[4] = a1.x; cbs[5] = a1.y; cbs[6] = a1.z; cbs[7] = a1.w; }
            const int nb = 2 * cgp + nbl;
#pragma unroll
            for (int s4 = 0; s4 < 4; ++s4) { wa[s4] = *(const bf16x8*)(P.GW + ((size_t)((0 * 16 + nb) * 64 + 32 * chh + l32) * 64 + 16 * s4 + 8 * hi));
                wi[s4] = *(const bf16x8*)(P.GW + ((size_t)((1 * 16 + nb) * 64 + 32 * chh + l32) * 64 + 16 * s4 + 8 * hi)); }
            const int ch = ch0 + chl; bga = P.gab[ch]; bgi = P.gib[ch]; const float z = -P.lam[ch];
            c8 = 8.0f * (fmaxf(z, 0.f) + log1pf(__expf(-fabsf(z)))); }
        const float nbga = -LOG2E * bga, nbgi = -LOG2E * bgi;
        { float xv[5][8];
#pragma unroll
          for (int k = 0; k < 5; ++k) unpack8(raw[k], xv[k]);
          if (smp && rg < 2) {
#pragma unroll
              for (int k = 0; k < 3; ++k) { const int tr = 2 * rg - 3 + k;
                  if (tr < 0) { const float* sp = P.lconv + (size_t)(sb * 3 + 3 + tr) * DM + chb; const f32x4 a0 = *(const f32x4*)sp, a1 = *(const f32x4*)(sp + 4);
                      xv[k][0] = a0.x; xv[k][1] = a0.y; xv[k][2] = a0.z; xv[k][3] = a0.w; xv[k][4] = a1.x; xv[k][5] = a1.y; xv[k][6] = a1.z; xv[k][7] = a1.w; } } }
          if (unit + G < NU) lru_load_x(P, unit + G, tid, raw);
          float y0[8], y1[8];
#pragma unroll
          for (int e = 0; e < 8; ++e) {
              y0[e] = cbs[e] + cwt[0][e] * xv[0][e] + cwt[1][e] * xv[1][e] + cwt[2][e] * xv[2][e] + cwt[3][e] * xv[3][e];
              y1[e] = cbs[e] + cwt[0][e] * xv[1][e] + cwt[1][e] * xv[2][e] + cwt[2][e] * xv[3][e] + cwt[3][e] * xv[4][e]; }
          *(LAS u32x4*)(XC + (2 * rg) * 272 + co * 16) = pack8(y0);
          *(LAS u32x4*)(XC + (2 * rg + 1) * 272 + co * 16) = pack8(y1);
          if (rg == 31 && (smp || cib == 127)) { float* o = smp ? P.olcs + (size_t)sb * 3 * DM : P.olcp + (size_t)(cidx >> 7) * 3 * DM;
#pragma unroll
              for (int j = 0; j < 3; ++j) { *(f32x4*)(o + j * DM + chb) = (f32x4){xv[2 + j][0], xv[2 + j][1], xv[2 + j][2], xv[2 + j][3]}; *(f32x4*)(o + j * DM + chb + 4) = (f32x4){xv[2 + j][4], xv[2 + j][5], xv[2 + j][6], xv[2 + j][7]}; } }
        }
        __syncthreads();
        { f32x16 ga = {}, gi = {};
#pragma unroll
          for (int s4 = 0; s4 < 4; ++s4) {
              const bf16x8 a = *(const LAS bf16x8*)(XC + (32 * rh + l32) * 272 + (64 * nbl + 16 * s4 + 8 * hi) * 2);
              ga = __builtin_amdgcn_mfma_f32_32x32x16_bf16(a, wa[s4], ga, 0, 0, 0);
              gi = __builtin_amdgcn_mfma_f32_32x32x16_bf16(a, wi[s4], gi, 0, 0, 0);
          }
#pragma unroll
          for (int r = 0; r < 16; ++r) { const int t = 32 * rh + crow(r, hi);
              const float xc = bf1(*(const LAS bf16*)(XC + t * 272 + chl * 2));
              const float ea = 1.f + __builtin_amdgcn_exp2f(fminf(__builtin_fmaf(ga[r], -LOG2E, nbga), 60.f)), ei = 1.f + __builtin_amdgcn_exp2f(fminf(__builtin_fmaf(gi[r], -LOG2E, nbgi), 60.f));
              const float rp = __builtin_amdgcn_rcpf(ea * ei), rr = ei * rp, ii = ea * rp, la = -c8 * rr;
              float e1 = la * (1.f + la * (0.5f + la * (1.f / 6 + la * (1.f / 24 + la * (1.f / 120 + la * (1.f / 720))))));
              if (__builtin_expect(la < -0.3f, 0)) e1 = __builtin_amdgcn_exp2f(la * LOG2E) - 1.f;
              const float a = 1.f + e1;
              const float uu = __builtin_amdgcn_sqrtf(fmaxf(-e1 * (2.f + e1), 0.f)) * ii * xc;
              AU[t * 128 + chl] = (f32x2){a, uu}; }
        }
        __syncthreads();
        { const int seg = tid >> 7, chs = tid & 127, ch = ch0 + chs; float hl[16], Al[16]; float h = 0.f, A = 1.f;
#pragma unroll
          for (int i = 0; i < 16; ++i) { const f32x2 au = AU[(16 * seg + i) * 128 + chs]; h = au.x * h + au.y; A *= au.x; hl[i] = h; Al[i] = A; }
          SEG[seg * 128 + chs] = (f32x2){A, h};
          __syncthreads();
          float cin = smp ? P.h0[(size_t)sb * DM + ch] : 0.f, Ain = 1.f;
#pragma unroll
          for (int s4 = 0; s4 < 3; ++s4) if (s4 < seg) { const f32x2 t = SEG[s4 * 128 + chs]; cin = t.x * cin + t.y; Ain *= t.x; }
#pragma unroll
          for (int i = 0; i < 16; ++i) { const size_t o = (size_t)(row0 + 16 * seg + i) * DM + ch; P.H[o] = f2bf(hl[i] + Al[i] * cin); P.AC[o] = f2bf(Al[i] * Ain); }
          if (seg == 3) { const float hf = hl[15] + Al[15] * cin; P.CTA[(size_t)cidx * DM + ch] = Al[15] * Ain; P.CTH[(size_t)cidx * DM + ch] = hf; if (smp) P.ohs[(size_t)sb * DM + ch] = hf; }
        }
        __syncthreads();
    }
}
struct AttnGeom { int tile0, qrow0, kvh, bc; bool smp; const bf16* kbase; const bf16* vbase; size_t vstride; };
__device__ __forceinline__ AttnGeom attn_geom(const P2Ptrs& P, int unit) {
    AttnGeom g; g.kvh = unit & 3; g.bc = unit >> 2; g.smp = g.bc >= 512;
    if (!g.smp) { const int b = g.bc >> 7, c = g.bc & 127; g.tile0 = c == 0 ? 4 : (c == 1 ? 2 : 0); const long tok0 = (long)b * SEQ + 64 * (c - 2);
        g.kbase = P.Kp + tok0 * 256 + g.kvh * 64; g.vbase = P.Vt + (size_t)(g.kvh * 64) * MP + tok0; g.vstride = MP; g.qrow0 = b * SEQ + 64 * c; }
    else { const int sb = g.bc - 512; g.tile0 = 0; g.kbase = P.KS + (size_t)(sb * 192) * 256 + g.kvh * 64; g.vbase = P.VTS + (size_t)(sb * 256 + g.kvh * 64) * 192; g.vstride = 192; g.qrow0 = MP + 64 * sb; }
    return g;
}
__device__ __forceinline__ void attn_load(const P2Ptrs& P, const AttnGeom& g, int tid, u32x4 (&kr)[3], u32x4 (&vr)[3], bf16x8 (&qf)[4]) {
    const int lane = tid & 63, wid = tid >> 6, l32 = lane & 31, hi = lane >> 5, key_first = g.tile0 * 32;
#pragma unroll
    for (int j = 0; j < 3; ++j) { const int idx = tid + 512 * j, row = idx >> 3, ch = idx & 7;
        if (row >= key_first) kr[j] = *(const u32x4*)(g.kbase + (long)row * 256 + ch * 8); }
#pragma unroll
    for (int j = 0; j < 3; ++j) { const int idx = tid + 512 * j, d = idx / 24, chk = idx % 24;
        if (chk * 8 >= key_first) vr[j] = *(const u32x4*)(g.vbase + (size_t)d * g.vstride + chk * 8); }
    const int h = g.kvh * 4 + (wid >> 1), qr = g.qrow0 + 32 * (wid & 1);
#pragma unroll
    for (int s = 0; s < 4; ++s) qf[s] = *(const bf16x8*)(P.Q + (size_t)(qr + l32) * DM + h * 64 + 16 * s + 8 * hi);
}
__device__ __forceinline__ void attn_phase(const P2Ptrs& P, LAS unsigned char* lds, int first, int end, int stride) {
    int tid_ = threadIdx.x; asm volatile("" : "+v"(tid_));
    const int tid = tid_, lane = tid & 63, wid = tid >> 6, l32 = lane & 31, hi = lane >> 5, g = wid >> 1;
    LAS unsigned char* Ks = lds;
    LAS unsigned char* Vs = lds + 27648;
    LAS unsigned char* OT = lds + 53248;
    u32x4 kr[3], vr[3]; bf16x8 qn[4];
#pragma unroll
    for (int j = 0; j < 3; ++j) { kr[j] = (u32x4){0u, 0u, 0u, 0u}; vr[j] = (u32x4){0u, 0u, 0u, 0u}; }
    if (first < end) { const AttnGeom G0 = attn_geom(P, first); attn_load(P, G0, tid, kr, vr, qn); }
    for (int unit = first; unit < end; unit += stride) {
        const AttnGeom G = attn_geom(P, unit);
        const int tile0 = G.tile0, key_first = tile0 * 32, kvh = G.kvh, qrow0 = G.qrow0, h = kvh * 4 + g;
#pragma unroll
        for (int j = 0; j < 3; ++j) { const int idx = tid + 512 * j, row = idx >> 3, ch = idx & 7;
            if (row >= key_first) *(LAS u32x4*)(Ks + row * 144 + ch * 16) = kr[j]; }
#pragma unroll
        for (int j = 0; j < 3; ++j) { const int idx = tid + 512 * j, d = idx / 24, chk = idx % 24;
            if (chk * 8 >= key_first) { *(LAS u32x2*)(Vs + d * 392 + chk * 16) = (u32x2){vr[j].x, vr[j].y}; *(LAS u32x2*)(Vs + d * 392 + chk * 16 + 8) = (u32x2){vr[j].z, vr[j].w}; } }
        bf16x8 qf[4];
#pragma unroll
        for (int s = 0; s < 4; ++s) qf[s] = qn[s];
        const float sink2 = P.sinks[h] * LOG2E;
        const int mrow = tid >> 3, mcg = tid & 7; u32x4 mh[4], mac[4], mgg[4], mga[4];
        __syncthreads();
        f32x16 p[6];
#pragma unroll
        for (int kt = 0; kt < 6; ++kt) { p[kt] = (f32x16){};
            if (kt >= tile0) {
#pragma unroll
                for (int s = 0; s < 4; ++s) { const bf16x8 a = *(const LAS bf16x8*)(Ks + (32 * kt + l32) * 144 + (16 * s + 8 * hi) * 2);
                    p[kt] = __builtin_amdgcn_mfma_f32_32x32x16_bf16(a, qf[s], p[kt], 0, 0, 0); } } }
        float mx = -3.0e38f;
#pragma unroll
        for (int kt = 0; kt < 6; ++kt) if (kt >= tile0) {
#pragma unroll
            for (int r = 0; r < 16; ++r) mx = fmaxf(mx, p[kt][r]); }
        mx = fmaxf(mx, __shfl_xor(mx, 32)); mx = fmaxf(mx, sink2);
        float l = 0.f;
#pragma unroll
        for (int kt = 0; kt < 6; ++kt) if (kt >= tile0) {
#pragma unroll
            for (int r = 0; r < 16; ++r) { const float e = __builtin_amdgcn_exp2f(p[kt][r] - mx); p[kt][r] = e; l += e; } }
        l += __shfl_xor(l, 32); l += __builtin_amdgcn_exp2f(sink2 - mx);
        f32x16 o[2]; o[0] = (f32x16){}; o[1] = (f32x16){};
#pragma unroll
        for (int kt = 0; kt < 6; ++kt) if (kt >= tile0) {
#pragma unroll
            for (int j = 0; j < 2; ++j) {
                u32x4 pw; pw.x = cvt_pk_bf16(p[kt][8 * j + 0], p[kt][8 * j + 1]); pw.y = cvt_pk_bf16(p[kt][8 * j + 2], p[kt][8 * j + 3]);
                pw.z = cvt_pk_bf16(p[kt][8 * j + 4], p[kt][8 * j + 5]); pw.w = cvt_pk_bf16(p[kt][8 * j + 6], p[kt][8 * j + 7]);
                const bf16x8 pa = __builtin_bit_cast(bf16x8, pw);
#pragma unroll
                for (int dt = 0; dt < 2; ++dt) { const LAS unsigned char* vp = Vs + (32 * dt + l32) * 392 + (32 * kt + 16 * j + 4 * hi) * 2;
                    const u32x2 lo = *(const LAS u32x2*)vp, hh = *(const LAS u32x2*)(vp + 16);
                    const bf16x8 vb = __builtin_bit_cast(bf16x8, (u32x4){lo.x, lo.y, hh.x, hh.y});
                    o[dt] = __builtin_amdgcn_mfma_f32_32x32x16_bf16(pa, vb, o[dt], 0, 0, 0); } } }
        asm volatile("" ::: "memory"); __builtin_amdgcn_sched_barrier(0);
        if (unit + stride < end) { const AttnGeom Gn = attn_geom(P, unit + stride); attn_load(P, Gn, tid, kr, vr, qn); }
#pragma unroll
        for (int k = 0; k < 4; ++k) { const size_t go = (size_t)(qrow0 + mrow) * DM + 256 * kvh + 64 * k + 8 * mcg;
            mh[k] = *(const u32x4*)(P.H + go); mac[k] = *(const u32x4*)(P.AC + go); mgg[k] = *(const u32x4*)(P.GG + go); mga[k] = *(const u32x4*)(P.GA + go); }
        const float linv = __builtin_amdgcn_rcpf(l);
#pragma unroll
        for (int r = 0; r < 16; ++r) { const int qq = crow(r, hi); const float li = __shfl(linv, qq);
            LAS bf16* op = (LAS bf16*)(OT + (32 * (wid & 1) + qq) * 528) + g * 64 + l32;
            op[0] = f2bf(o[0][r] * li); op[32] = f2bf(o[1][r] * li); }
        __syncthreads();
        { const int row = tid >> 3, cgp = tid & 7; const int grow = qrow0 + row;
#pragma unroll
          for (int k = 0; k < 4; ++k) { const int cl = 64 * k + 8 * cgp, c8 = 256 * kvh + cl; const size_t go = (size_t)grow * DM + c8;
              float ya[8], hh[8], ac[8], gg[8], ga[8], hp[8];
              unpack8(*(const LAS u32x4*)(OT + row * 528 + cl * 2), ya);
              unpack8(mh[k], hh); unpack8(mac[k], ac); unpack8(mgg[k], gg); unpack8(mga[k], ga);
              if (!G.smp) { const f32x4 h0 = *(const f32x4*)(P.HP + (size_t)G.bc * DM + c8), h1 = *(const f32x4*)(P.HP + (size_t)G.bc * DM + c8 + 4);
                  hp[0] = h0.x; hp[1] = h0.y; hp[2] = h0.z; hp[3] = h0.w; hp[4] = h1.x; hp[5] = h1.y; hp[6] = h1.z; hp[7] = h1.w; }
              else {
#pragma unroll
                  for (int e = 0; e < 8; ++e) hp[e] = 0.f; }
              float mx8[8];
#pragma unroll
              for (int e = 0; e < 8; ++e) mx8[e] = gg[e] * (hh[e] + ac[e] * hp[e]) + ga[e] * ya[e];
              *(u32x4*)(P.MIX + go) = pack8(mx8); } }
        __syncthreads();
    }
}

#define XB_TMO      128
#define XB_XCNT(j)  (256  + 64 * (j))
#define XB_XSUB(j)  (1280 + 64 * (j))
#define XB_XGEN(j)  (2304 + 64 * (j))
#define XB_TOP      3328
#define XB_TOPGEN   3392
#define XCD_BAR_WORDS 3456
#define XB_SPIN_CAP (1u << 18)

__device__ __forceinline__ unsigned xb_ld(unsigned* p)              { return __hip_atomic_load(p, __ATOMIC_RELAXED, __HIP_MEMORY_SCOPE_AGENT); }
__device__ __forceinline__ unsigned xb_add(unsigned* p, unsigned v) { return __hip_atomic_fetch_add(p, v, __ATOMIC_RELAXED, __HIP_MEMORY_SCOPE_AGENT); }
__device__ __forceinline__ unsigned xb_xcc_id() { return (unsigned)__builtin_amdgcn_s_getreg((3 << 11) | 20) & 0xFu; }
#define XB_SPIN(cond, bar) do { unsigned _sp = 0; while (cond) { __builtin_amdgcn_s_sleep(1); \
    if ((++_sp & 255u) == 0u) { if (xb_ld(&(bar)[XB_TMO])) break; if (_sp > XB_SPIN_CAP) { atomicAdd(&(bar)[XB_TMO], 1u); break; } } } } while (0)

struct XcdBarrier {
    unsigned* bar; unsigned x;
    volatile LAS unsigned* st;
};

__device__ __forceinline__ XcdBarrier xcd_barrier_post(unsigned* bar, volatile LAS unsigned* st) {
    XcdBarrier b; b.bar = bar; b.x = xb_xcc_id(); b.st = st;
    if (threadIdx.x == 0) (void)xb_add(&bar[XB_XCNT(b.x)], 1u);
    return b;
}
__device__ __forceinline__ void xcd_barrier_complete(unsigned* bar, unsigned x, unsigned& nloc, unsigned& nx) {
    const unsigned G = gridDim.x * gridDim.y * gridDim.z;
    unsigned sum, cnt, mine, sp = 0u;
    for (;;) {
        sum = 0u; cnt = 0u; mine = 0u;
#pragma unroll
        for (unsigned j = 0; j < 16; ++j) { const unsigned c = xb_ld(&bar[XB_XCNT(j)]); sum += c; cnt += (c > 0u) ? 1u : 0u; mine = (j == x) ? c : mine; }
        if (sum == G) break;
        __builtin_amdgcn_s_sleep(1);
        if ((++sp & 255u) == 0u) { if (xb_ld(&bar[XB_TMO])) break; if (sp > XB_SPIN_CAP) { atomicAdd(&bar[XB_TMO], 1u); break; } }
    }
    nloc = mine > 0u ? mine : 1u; nx = cnt > 0u ? cnt : 1u;
}

__device__ __forceinline__ void xcd_barrier(const XcdBarrier& b) {
    asm volatile("s_waitcnt vmcnt(0)" ::: "memory");
    __syncthreads();
    if (threadIdx.x == 0) {
        unsigned* bar = b.bar;
        __builtin_amdgcn_s_waitcnt(0);
        unsigned nloc = b.st[0], nx = b.st[1];
        if (nloc == 0u) { xcd_barrier_complete(bar, b.x, nloc, nx); b.st[0] = nloc; b.st[1] = nx; }
        const unsigned old = xb_add(&bar[XB_XSUB(b.x)], 1u);
        const unsigned gen = old / nloc;
        if (old + 1u == (gen + 1u) * nloc) {
            __builtin_amdgcn_fence(__ATOMIC_RELEASE, "agent");
            asm volatile("s_waitcnt vmcnt(0)" ::: "memory");
            const unsigned og = xb_add(&bar[XB_TOP], 1u);
            const unsigned tg = og / nx;
            if (og + 1u == (tg + 1u) * nx) xb_add(&bar[XB_TOPGEN], 1u);
            else XB_SPIN(xb_ld(&bar[XB_TOPGEN]) == tg, bar);
            __builtin_amdgcn_fence(__ATOMIC_ACQUIRE, "agent");
            xb_add(&bar[XB_XGEN(b.x)], 1u);
            asm volatile("s_waitcnt vmcnt(0)" ::: "memory");
        } else {
            XB_SPIN(xb_ld(&bar[XB_XGEN(b.x)]) == gen, bar);
            __builtin_amdgcn_fence(__ATOMIC_ACQUIRE, "agent");
            asm volatile("s_waitcnt vmcnt(0)" ::: "memory");
        }
    }
    __syncthreads();
}

struct Args { const float* in[24]; float* out; unsigned char* ws; int ph_lo, ph_hi; };
__global__ void __launch_bounds__(512, 2) fwd_kernel(Args args) {
    extern __shared__ __attribute__((aligned(16))) unsigned char lds_raw[];
    LAS unsigned char* lds = (LAS unsigned char*)lds_raw;
    Ctx C;
#pragma unroll
    for (int i = 0; i < 24; ++i) C.in[i] = args.in[i];
    C.out = args.out; C.ws = args.ws; C.tid = threadIdx.x; C.lane = C.tid & 63; C.wave = __builtin_amdgcn_readfirstlane(C.tid >> 6); C.G = gridDim.x; C.bid = blockIdx.x;
    unsigned char* ws = args.ws; float* out = args.out;
    const int lo = args.ph_lo, hi = args.ph_hi;
    volatile LAS unsigned* MISC = (volatile LAS unsigned*)(lds + LDS_MISC);
    if (threadIdx.x < 16) MISC[threadIdx.x] = 0u;
    __syncthreads();
    XcdBarrier bar = xcd_barrier_post((unsigned*)ws, MISC + 8);
#define IN(k) (lo <= (k) && (k) < hi)
#define SEAM(k) do { if (IN(k) && IN((k) + 1)) xcd_barrier(bar); } while (0)
    bf16* B0 = (bf16*)(ws + WS_B0); bf16* XR = (bf16*)(ws + WS_XR); bf16* GG = (bf16*)(ws + WS_GG); bf16* Qb = (bf16*)(ws + WS_Q); bf16* GA = (bf16*)(ws + WS_GA); bf16* AC = (bf16*)(ws + WS_AC);
    bf16* Kp = (bf16*)(ws + WS_K); bf16* KS = (bf16*)(ws + WS_KS); bf16* Vt = (bf16*)(ws + WS_VT); bf16* VTS = (bf16*)(ws + WS_VTS); bf16* HID = (bf16*)(ws + WS_HID);
    float* rstd1 = (float*)(ws + WS_RSTD1); float* ss2 = (float*)(ws + WS_SS2); float* ss3 = (float*)(ws + WS_SS3);
    float* Y2 = (float*)(ws + WS_FU);
    float* CTA = (float*)(ws + WS_CTA); float* CTH = (float*)(ws + WS_CTH); float* HP = (float*)(ws + WS_HP); float* FU = (float*)(ws + WS_FU); float* HU = (float*)(ws + WS_HU);

    if (IN(0)) p0_prologue(C, lds);
    SEAM(0);
    if (IN(1)) {
        { pg8::Gemm g{B0, (const bf16*)(ws + WS_WIN), MT, NMAIN, DM}; pg8::StaticOrder S; S.init(MT, NMAIN, C.G, C.bid);
          EpiMain E{XR, GG, Qb, Kp, KS, GA, rstd1, (const float*)(ws + WS_ROPE), out + O_KP, out + O_KS};
          pg8::gemm_phase<EpiMain, pg8::StaticOrder, true, true>(lds, g, S, E); }
        { pg8::Gemm g{(const bf16*)(ws + WS_WIN) + (size_t)NMAIN * DM, B0, 256, MT, DM}; OffsetOrder S; S.init(256, MT, C.G, C.bid, ((MT / 256) * (NMAIN / 256)) % C.G);
          EpiVt E{Vt, VTS, rstd1, out + O_VP, out + O_VS};
          pg8::gemm_phase<EpiVt, OffsetOrder, true, true>(lds, g, S, E); }
    }
    SEAM(1);
    if (IN(2)) {
        P2Ptrs P{XR, Qb, Kp, KS, Vt, VTS, (const bf16*)(ws + WS_GW), B0, AC, XR, CTA, CTH, GG, GA, HP,
                 C.in[5], C.in[9], C.in[10], C.in[12], C.in[14], C.in[15], C.in[4], C.in[16], out + O_LCP, out + O_LCS, out + O_HS};
        lru_phase(P, lds, C.bid, C.G);
    }
    SEAM(2);
    if (IN(3)) {
        if (C.bid < 32) {
            int t3 = threadIdx.x; asm volatile("" : "+v"(t3));
            const int b = C.bid >> 3, ch = (C.bid & 7) * 128 + (t3 & 127), seg = t3 >> 7; const size_t base = (size_t)(b * 128 + seg * 32) * DM + ch;
            float a[32], h[32];
#pragma unroll
            for (int i = 0; i < 32; ++i) { a[i] = CTA[base + (size_t)i * DM]; h[i] = CTH[base + (size_t)i * DM]; }
            float As = 1.f, hs = 0.f;
#pragma unroll
            for (int i = 0; i < 32; ++i) { hs = a[i] * hs + h[i]; As *= a[i]; }
            LAS f32x2* SG = (LAS f32x2*)lds;
            SG[seg * 128 + (t3 & 127)] = (f32x2){As, hs};
            __syncthreads();
            float carry = 0.f;
#pragma unroll
            for (int s4 = 0; s4 < 3; ++s4) if (s4 < seg) { const f32x2 t = SG[s4 * 128 + (t3 & 127)]; carry = t.x * carry + t.y; }
#pragma unroll
            for (int i = 0; i < 32; ++i) { HP[base + (size_t)i * DM] = carry; carry = a[i] * carry + h[i]; }
            if (seg == 3) out[O_HP + b * DM + ch] = carry;
            __syncthreads();
        } else {
            P2Ptrs P{XR, Qb, Kp, KS, Vt, VTS, (const bf16*)(ws + WS_GW), B0, AC, XR, CTA, CTH, GG, GA, HP,
                     C.in[5], C.in[9], C.in[10], C.in[12], C.in[14], C.in[15], C.in[4], C.in[16], out + O_LCP, out + O_LCS, out + O_HS};
            attn_phase(P, lds, 2048 + C.bid - 32, 2048 + 128, C.G - 32);
        }
    }
    SEAM(3);
    if (IN(4)) {
        if (C.bid < 32) {
            pg8::Gemm g{XR, (const bf16*)(ws + WS_WOUT), MT, DM, DM}; RowOrder S; S.init(MS, DM, C.G, C.bid, MP / 256);
            EpiWout E{C.in[0], C.in[1], B0, ss2};
            pg8::gemm_phase<EpiWout, RowOrder, true, true>(lds, g, S, E);
            __syncthreads();
        }
        {
            P2Ptrs P{XR, Qb, Kp, KS, Vt, VTS, (const bf16*)(ws + WS_GW), B0, AC, XR, CTA, CTH, GG, GA, HP,
                     C.in[5], C.in[9], C.in[10], C.in[12], C.in[14], C.in[15], C.in[4], C.in[16], out + O_LCP, out + O_LCS, out + O_HS};
            constexpr int ATT_TAIL = 5, NSTR = 2048 - 32 * ATT_TAIL;
            if (C.bid < 32) attn_phase(P, lds, NSTR + ATT_TAIL * C.bid, NSTR + ATT_TAIL * (C.bid + 1), 1);
            else attn_phase(P, lds, C.bid - 32, NSTR, C.G - 32);
        }
    }
    SEAM(4);
    if (IN(5)) {
        pg8::Gemm g{XR, (const bf16*)(ws + WS_WOUT), MT, DM, DM}; RowOrder S; S.init(MP, DM, C.G, C.bid, 0);
        EpiWout E{C.in[0], C.in[1], B0, ss2};
        pg8::gemm_phase<EpiWout, RowOrder, true, true>(lds, g, S, E);
    }
    SEAM(5);
    if (IN(6)) {
        pg8::Gemm g{B0, (const bf16*)(ws + WS_WUP), MT, DIN, DM}; pg8::StaticOrder S; S.init(MT, DIN, C.G, C.bid);
        EpiUp E{HID, ss2, C.in[20], C.in[21], C.in[6], FU, HU, out + O_FCP, out + O_FCS, lds + LDS_EX};
        pg8::gemm_phase<EpiUp, pg8::StaticOrder, true, true>(lds, g, S, E);
    }
    SEAM(6);
    if (IN(7)) {
        RowOrder S; S.init(MP, DM, C.G, C.bid, 0);
        { pg8::Unit u; int last = -1; const float* cw = C.in[20]; const float* cb = C.in[21];
          for (int i = 0; S.next(i, u); ++i) { const int pm = u.pm; if (pm == last) continue; last = pm; if (pm >= 128 || (pm & 31) == 0) continue;
              int t7p = threadIdx.x; asm volatile("" : "+v"(t7p));
              for (int ch = t7p; ch < DFF; ch += 512) { const int pnp = ch >> 7, o = ch & 127, gc = pnp * 256 + o, vc = gc + 128;
                  const float* hu = HU + (size_t)((pm - 1) * 2) * DIN; const float* fu = FU + (size_t)(pm * 2) * DIN;
                  const float g2 = hu[gc], g1 = hu[DIN + gc], g0 = fu[gc], gp = fu[DIN + gc], v2 = hu[vc], v1 = hu[DIN + vc], v0 = fu[vc], vp = fu[DIN + vc];
                  const float wg0 = cw[ch], wg1 = cw[DIN + ch], wg2 = cw[2 * DIN + ch], bg = cb[ch], wv0 = cw[DFF + ch], wv1 = cw[DIN + DFF + ch], wv2 = cw[2 * DIN + DFF + ch], bv = cb[DFF + ch];
                  const float ga = bg + wg0 * g2 + wg1 * g1 + wg2 * g0, va = bv + wv0 * v2 + wv1 * v1 + wv2 * v0;
                  const float gb = bg + wg0 * g1 + wg1 * g0 + wg2 * gp, vb = bv + wv0 * v1 + wv1 * v0 + wv2 * vp;
                  HID[(size_t)(pm * 256) * DFF + ch] = f2bf(ga * sigmoidf_(ga) * va); HID[(size_t)(pm * 256 + 1) * DFF + ch] = f2bf(gb * sigmoidf_(gb) * vb); } }
          asm volatile("s_waitcnt vmcnt(0)" ::: "memory"); __syncthreads(); }
        pg8::Gemm g{HID, (const bf16*)(ws + WS_WDN), MT, DM, DFF};
        EpiDown E{B0, out + O_Y, ss3};
        pg8::gemm_phase<EpiDown, RowOrder, true, true>(lds, g, S, E);
    }
    SEAM(7);
#define NORM_ROWS(first_row, n_rows, gwv, ngwv) do { int t7 = threadIdx.x; asm volatile("" : "+v"(t7)); const int lane7 = t7 & 63; const float* gf = C.in[23]; \
        f32x4 gv[4]; _Pragma("unroll") for (int j = 0; j < 4; ++j) gv[j] = ((const f32x4*)gf)[lane7 + 64 * j]; \
        for (int m0 = (first_row) + ((gwv) * 8 + (t7 >> 6)) * 4; m0 < (first_row) + (n_rows); m0 += (ngwv) * 8 * 4) { f32x4 v[4][4]; float rs[4]; \
            _Pragma("unroll") for (int r = 0; r < 4; ++r) { const f32x4* yr = (const f32x4*)(out + O_Y + (size_t)(m0 + r) * DM) + lane7; \
                _Pragma("unroll") for (int j = 0; j < 4; ++j) v[r][j] = yr[64 * j]; } \
            _Pragma("unroll") for (int r = 0; r < 4; ++r) { float sq = 0.f; _Pragma("unroll") for (int j = 0; j < 4; ++j) sq += (v[r][j].x * v[r][j].x + v[r][j].y * v[r][j].y) + (v[r][j].z * v[r][j].z + v[r][j].w * v[r][j].w); \
                rs[r] = __builtin_amdgcn_rsqf(wave_sum(sq) * (1.0f / DM) + RMS_EPS); } \
            _Pragma("unroll") for (int r = 0; r < 4; ++r) { f32x4* yr = (f32x4*)(out + O_Y + (size_t)(m0 + r) * DM) + lane7; \
                _Pragma("unroll") for (int j = 0; j < 4; ++j) yr[64 * j] = v[r][j] * rs[r] * gv[j]; } } } while (0)
    if (IN(8)) {
        if (C.bid < 64) {
            const int kh = C.bid & 1; RowOrder S; S.init(MS, DM, C.G, C.bid >> 1, MP / 256);
            pg8::Gemm g{HID + kh * (DFF / 2), (const bf16*)(ws + WS_WDN) + kh * (DFF / 2), MT, DM, DFF / 2, DFF};
            EpiDown E{kh ? (const bf16*)nullptr : B0, kh ? Y2 - (size_t)MP * DM : out + O_Y, ss3};
            pg8::gemm_phase<EpiDown, RowOrder, true, true>(lds, g, S, E);
        } else { NORM_ROWS(0, MP, C.bid - 64, C.G - 64); }
    }
    SEAM(8);
    if (IN(9)) { int t9 = threadIdx.x; asm volatile("" : "+v"(t9)); const int lane9 = t9 & 63; const float* gf = C.in[23];
        for (int m = MP + C.bid * 8 + (t9 >> 6); m < MT; m += C.G * 8) { f32x4* yr = (f32x4*)(out + O_Y + (size_t)m * DM) + lane9; const f32x4* y2 = (const f32x4*)(Y2 + (size_t)(m - MP) * DM) + lane9;
            f32x4 v[4]; float sq = 0.f;
#pragma unroll
            for (int j = 0; j < 4; ++j) { v[j] = yr[64 * j] + y2[64 * j]; sq += (v[j].x * v[j].x + v[j].y * v[j].y) + (v[j].z * v[j].z + v[j].w * v[j].w); }
            const float rs = __builtin_amdgcn_rsqf(wave_sum(sq) * (1.0f / DM) + RMS_EPS);
#pragma unroll
            for (int j = 0; j < 4; ++j) yr[64 * j] = v[j] * rs * ((const f32x4*)gf)[lane9 + 64 * j]; } }
#undef IN
#undef SEAM
#undef NORM_ROWS
}

extern "C" void kernel_launch(void* const* d_in, const int* in_sizes, int n_in, void* d_out, int out_size, void* d_ws, size_t ws_size, hipStream_t stream) {
    static int grid = 0;
    if (grid == 0) {
        if (n_in != 24 || out_size != (int)O_END || ws_size < WS_END) { fprintf(stderr, "kernel_launch: unexpected shapes: n_in %d out %d ws %zu\n", n_in, out_size, ws_size); grid = -1; return; }
        int dev = 0, cus = 0, per_cu = 0;
        (void)hipGetDevice(&dev); (void)hipDeviceGetAttribute(&cus, hipDeviceAttributeMultiprocessorCount, dev);
        (void)hipFuncSetAttribute((const void*)fwd_kernel, hipFuncAttributeMaxDynamicSharedMemorySize, LDS_BYTES);
        (void)hipOccupancyMaxActiveBlocksPerMultiprocessor(&per_cu, (const void*)fwd_kernel, 512, LDS_BYTES);
        if (per_cu < 1) { fprintf(stderr, "kernel_launch: occupancy query says %d blocks per CU\n", per_cu); grid = -1; return; }
        grid = cus;
    }
    if (grid < 0) return;
    Args a{};
    for (int i = 0; i < 24; ++i) a.in[i] = (const float*)d_in[i];
    a.out = (float*)d_out; a.ws = (unsigned char*)d_ws;
    a.ph_lo = 0; a.ph_hi = 10;
    if (hipMemsetAsync(d_ws, 0, 16384, stream) != hipSuccess) { fprintf(stderr, "kernel_launch: memset of the barrier words failed\n"); return; }
    hipLaunchKernelGGL(fwd_kernel, dim3(grid), dim3(512), LDS_BYTES, stream, a);
}
```
